# Optimizing an MI355X kernel written in HIP

```python
import math
import jax, jax.numpy as jnp
from jax import lax
import numpy as np

D_MODEL = 1024
BATCH = 32
SEQ = 2048
DEPTH = 1

N_MEM = 256
MLSTM_HEADS = 4
MLSTM_HEAD_DIM = D_MODEL // 8
SB_HEADS = 4
SB_HEAD_DIM = D_MODEL // 16
MEM_HEADS = 4
MEM_HEAD_DIM = D_MODEL // 16
D_MLSTM = MLSTM_HEADS * MLSTM_HEAD_DIM
D_SB = SB_HEADS * SB_HEAD_DIM
D_MEMX = MEM_HEADS * MEM_HEAD_DIM
D_MIX = D_MLSTM + D_SB + D_MEMX
CONV_WIDTH = 4
CHUNK = 128
Q_BLOCK = 128
EPS = 1e-6
SPLIT_SIZES = (D_MLSTM,) * 5 + (MLSTM_HEADS, MLSTM_HEADS) + (D_SB,) * 4 + (D_MEMX,) * 2
D_IN = sum(SPLIT_SIZES)

kernel_name = "hybrid_mlstm_stickbreak_memxattn_layer"


def rmsnorm(x, g):
    xf = x.astype(jnp.float32)
    y = xf * lax.rsqrt(jnp.mean(xf * xf, axis=-1, keepdims=True) + EPS)
    return (y * g.astype(jnp.float32)).astype(x.dtype)


def head_rmsnorm(h, g):
    y = h * lax.rsqrt(jnp.mean(h * h, axis=-1, keepdims=True) + EPS)
    return y * g.astype(jnp.float32).reshape(h.shape[-2:])


def split_heads(a, n):
    return a.reshape(a.shape[:-1] + (n, a.shape[-1] // n))


def causal_dwconv(x, w, b):
    c = x.shape[-1]
    y = lax.conv_general_dilated(x, w[:, None, :], window_strides=(1,),
                                 padding=[(w.shape[0] - 1, 0)],
                                 dimension_numbers=("NWC", "WIO", "NWC"),
                                 feature_group_count=c)
    return y + b


def mlstm_chunkwise(q, k, v, i_pre, f_pre):
    B, S, H, d = q.shape
    nc = S // CHUNK
    k = k * (d ** -0.5)
    logf = jax.nn.log_sigmoid(f_pre)

    def chunks4(a):
        return a.reshape(B, nc, CHUNK, H, a.shape[-1]).transpose(1, 0, 3, 2, 4)

    def chunks3(a):
        return a.reshape(B, nc, CHUNK, H).transpose(1, 0, 3, 2)

    mask = jnp.tril(jnp.ones((CHUNK, CHUNK), dtype=bool))

    def step(carry, inp):
        C, n, m = carry
        qb, kb, vb, ib, fb = inp
        b = jnp.cumsum(fb, axis=-1)
        dmat = b[..., :, None] - b[..., None, :] + ib[..., None, :]
        dmat = jnp.where(mask, dmat, -jnp.inf)
        inter = b + m[..., None]
        m_t = jnp.maximum(inter, jnp.max(dmat, axis=-1))
        dexp = jnp.exp(dmat - m_t[..., None])
        inter_w = jnp.exp(inter - m_t)
        s = jnp.einsum("bhtd,bhsd->bhts", qb, kb) * dexp
        num = (jnp.einsum("bhts,bhse->bhte", s, vb)
               + inter_w[..., None] * jnp.einsum("bhtd,bhde->bhte", qb, C))
        den = jnp.sum(s, axis=-1) + inter_w * jnp.einsum("bhtd,bhd->bht", qb, n)
        h = num / jnp.maximum(jnp.abs(den), jnp.exp(-m_t))[..., None]
        b_last = b[..., -1]
        a_end = b_last[..., None] - b + ib
        m_new = jnp.maximum(b_last + m, jnp.max(a_end, axis=-1))
        w_end = jnp.exp(a_end - m_new[..., None])
        decay = jnp.exp(b_last + m - m_new)
        C_new = decay[..., None, None] * C + jnp.einsum("bhs,bhsd,bhse->bhde", w_end, kb, vb)
        n_new = decay[..., None] * n + jnp.einsum("bhs,bhsd->bhd", w_end, kb)
        return (C_new, n_new, m_new), h

    init = (jnp.zeros((B, H, d, v.shape[-1]), jnp.float32),
            jnp.zeros((B, H, d), jnp.float32),
            jnp.zeros((B, H), jnp.float32))
    _, hs = lax.scan(step, init, (chunks4(q), chunks4(k), chunks4(v), chunks3(i_pre), chunks3(logf)))
    return hs.transpose(1, 0, 3, 2, 4).reshape(B, S, H, v.shape[-1])


def stick_breaking_attention(q, k, v):
    B, S, H, d = q.shape
    scale = d ** -0.5
    outs = []
    for blk in range(S // Q_BLOCK):
        t0 = blk * Q_BLOCK
        t1 = t0 + Q_BLOCK
        qb, kb, vb = q[:, t0:t1], k[:, :t1], v[:, :t1]
        z = jnp.einsum("bthd,bshd->bhts", qb, kb) * scale
        strict = jnp.arange(t1)[None, :] < (t0 + jnp.arange(Q_BLOCK))[:, None]
        sp = jax.nn.softplus(z)
        log_beta = z - sp
        log_1m = jnp.where(strict, -sp, 0.0)
        suffix = lax.cumsum(log_1m, axis=3, reverse=True) - log_1m
        a = jnp.where(strict, jnp.exp(log_beta + suffix), 0.0)
        outs.append(jnp.einsum("bhts,bshd->bthd", a, vb))
    return jnp.concatenate(outs, axis=1)


def memory_cross_attention(q, k, v):
    scores = jnp.einsum("bthd,bmhd->bhtm", q, k) * (q.shape[-1] ** -0.5)
    p = jax.nn.softmax(scores, axis=-1)
    return jnp.einsum("bhtm,bmhd->bthd", p, v)


def setup_inputs(seed: int = 0) -> dict:
    key = jax.random.key(seed)
    ks = jax.random.split(key, 16)
    f32 = jnp.float32
    nrm = lambda k, s: jax.random.normal(k, s, f32)
    return {
        "x": nrm(ks[0], (BATCH, SEQ, D_MODEL)),
        "mem": nrm(ks[1], (BATCH, N_MEM, D_MODEL)),
        "g_pre": 1.0 + 0.05 * nrm(ks[2], (D_MODEL,)),
        "w_in": nrm(ks[3], (D_MODEL, D_IN)) * D_MODEL ** -0.5,
        "conv_w": nrm(ks[4], (CONV_WIDTH, 2 * D_MLSTM)) * CONV_WIDTH ** -0.5,
        "conv_b": 0.01 * nrm(ks[5], (2 * D_MLSTM,)),
        "i_bias": 0.1 * nrm(ks[6], (MLSTM_HEADS,)),
        "f_bias": jnp.linspace(3.0, 6.0, MLSTM_HEADS, dtype=f32) + 0.1 * nrm(ks[7], (MLSTM_HEADS,)),
        "g_mlstm_head": 1.0 + 0.05 * nrm(ks[8], (D_MLSTM,)),
        "g_sb_head": 1.0 + 0.05 * nrm(ks[9], (D_SB,)),
        "g_mem_head": 1.0 + 0.05 * nrm(ks[10], (D_MEMX,)),
        "g_mem": 1.0 + 0.05 * nrm(ks[11], (D_MODEL,)),
        "w_mem_kv": nrm(ks[12], (D_MODEL, 2 * D_MEMX)) * D_MODEL ** -0.5,
        "w_out": nrm(ks[13], (D_MIX, D_MODEL)) * D_MIX ** -0.5,
        "g_post": 1.0 + 0.05 * nrm(ks[14], (D_MODEL,)),
    }


def reference(x, mem, g_pre, w_in, conv_w, conv_b, i_bias, f_bias, g_mlstm_head, g_sb_head,
              g_mem_head, g_mem, w_mem_kv, w_out, g_post):
    f32 = jnp.float32
    dt = x.dtype
    B, S, _ = x.shape
    split_idx = [int(i) for i in np.cumsum(SPLIT_SIZES)[:-1]]
    for _layer in range(DEPTH):
        h = rmsnorm(x, g_pre)
        u = h @ w_in
        (q_m, k_m, v_m, o_m, z_m, i_m, f_m,
         q_s, k_s, v_s, z_s, q_c, z_c) = jnp.split(u, split_idx, axis=-1)

        qk = causal_dwconv(jnp.concatenate([q_m, k_m], axis=-1).astype(f32),
                           conv_w.astype(f32), conv_b.astype(f32))
        q_m2, k_m2 = jnp.split(jax.nn.silu(qk), 2, axis=-1)
        h_m = mlstm_chunkwise(split_heads(q_m2, MLSTM_HEADS), split_heads(k_m2, MLSTM_HEADS),
                              split_heads(v_m.astype(f32), MLSTM_HEADS),
                              i_m.astype(f32) + i_bias.astype(f32),
                              f_m.astype(f32) + f_bias.astype(f32))
        h_m = jax.nn.sigmoid(o_m.astype(f32)) * head_rmsnorm(h_m, g_mlstm_head).reshape(B, S, D_MLSTM)
        y_m = h_m * jax.nn.silu(z_m.astype(f32))

        h_s = stick_breaking_attention(split_heads(q_s.astype(f32), SB_HEADS),
                                       split_heads(k_s.astype(f32), SB_HEADS),
                                       split_heads(v_s.astype(f32), SB_HEADS))
        y_s = head_rmsnorm(h_s, g_sb_head).reshape(B, S, D_SB) * jax.nn.silu(z_s.astype(f32))

        kv = rmsnorm(mem, g_mem) @ w_mem_kv
        k_c, v_c = jnp.split(kv.astype(f32), 2, axis=-1)
        h_c = memory_cross_attention(split_heads(q_c.astype(f32), MEM_HEADS),
                                     split_heads(k_c, MEM_HEADS), split_heads(v_c, MEM_HEADS))
        y_c = head_rmsnorm(h_c, g_mem_head).reshape(B, S, D_MEMX) * jax.nn.silu(z_c.astype(f32))

        y = jnp.concatenate([y_m, y_s, y_c], axis=-1).astype(dt) @ w_out
        x = x + rmsnorm(y, g_post)
    return x
```

```cpp
#include <hip/hip_runtime.h>
#include <hip/hip_cooperative_groups.h>
#include <cstdio>
#include <cstdint>
namespace cg = cooperative_groups;
namespace pg8 {
#define PG8_LAS __attribute__((address_space(3)))
typedef unsigned short bf16_t;
typedef short bf16x8 __attribute__((ext_vector_type(8)));
typedef float f32x4 __attribute__((ext_vector_type(4)));
typedef unsigned u32x4 __attribute__((ext_vector_type(4)));
constexpr int BM = 256, BK = 64, HALF = 128, HTB = HALF * BK * 2  , STAGE_BYTES = 8 * HTB, NXCD = 8, WGM = 8;

__host__ __device__ __forceinline__ int lds_byte(int r, int c) { const int st = (r >> 4) * 2 + (c >> 5), rr = r & 15, cc = c & 31, ob = rr * 64 + cc * 2; return st * 1024 + (ob ^ (((ob >> 9) & 1) << 5)); }
__host__ __device__ __forceinline__ void stage_rc(int b, int& R, int& C) { const int st = b / 1024, sb = b % 1024, swz = sb ^ (((sb >> 9) & 1) << 5); R = (st >> 1) * 16 + swz / 64; C = (st & 1) * 32 + (swz % 64) / 2; }
__host__ __device__ __forceinline__ int perm32(int rho) { const int n = rho >> 4, i = rho & 15; return 8 * (i >> 2) + 4 * n + (i & 3); }

struct Unit { int pm, pn; };
struct Gemm { const bf16_t* A; const bf16_t* Bt; int M, N, K; };

struct StaticOrder {
    int nM, nN, nwg, G, c;
    __host__ __device__ void init(int M, int N, int G_, int c_) { nM = M / BM; nN = N / BM; nwg = nM * nN; G = G_; c = c_; }
    __host__ __device__ bool next(int i, Unit& u) const {
        const long L = (long)i * G + c; if (L >= nwg) return false;
        int wgid = (int)L; { const int q = nwg / NXCD, r = nwg % NXCD, xcd = wgid % NXCD, off = wgid / NXCD; wgid = (xcd < r ? xcd * (q + 1) : r * (q + 1) + (xcd - r) * q) + off; }
        const int nig = WGM * nN, gid = wgid / nig, fm = gid * WGM, gsz = (nM - fm) < WGM ? (nM - fm) : WGM;
        u.pm = fm + ((wgid % nig) % gsz); u.pn = (wgid % nig) / gsz; return true;
    }
    __device__ __forceinline__ void a_ready(const Unit&) const {}
    __device__ __forceinline__ void done(const Unit&) const {}
};

__device__ __forceinline__ unsigned cvt_pk_bf16(float lo, float hi) { unsigned r; asm volatile("v_cvt_pk_bf16_f32 %0, %1, %2" : "=v"(r) : "v"(lo), "v"(hi)); return r; }
typedef float f32x2 __attribute__((ext_vector_type(2)));
__device__ __forceinline__ f32x2 gelu_pk(f32x2 v) {
    const f32x2 av = __builtin_elementwise_abs(v), d = av * 0.2316418882f + 1.0f;
    f32x2 t; t.x = __builtin_amdgcn_rcpf(d.x); t.y = __builtin_amdgcn_rcpf(d.y);
    f32x2 q = t * 0.5307027145f + (-0.7265760135f); q = q * t + 0.7107068705f; q = q * t + (-0.142248368f); q = q * t + 0.127414796f; q = q * t;
    const f32x2 s = (v * v) * (-0.72134752044f);
    f32x2 e; e.x = __builtin_amdgcn_exp2f(s.x); e.y = __builtin_amdgcn_exp2f(s.y);
    const f32x2 m = v * (q * e), r = v - m;
    f32x2 o; o.x = v.x < 0.f ? m.x : r.x; o.y = v.y < 0.f ? m.y : r.y; return o;
}

template <int ACT  > struct EpiBf16 {
    static constexpr bool PERM = true, AFTER_DRAIN = false; static_assert(ACT == 0 || ACT == 1, "EpiBf16: ACT is 0 (none) or 1 (gelu_pk)");
    bf16_t* O; int ldc; const float* bias; int split_cols; size_t split_stride; float scale0;
    __device__ __forceinline__ void operator()(const f32x4 (&acc)[2][2][4][2], const Unit& u, int wr, int wc, int fr, int fq) const {
        const int row0 = u.pm * BM + wr * 64 + fr; int colt = u.pn * BM; bf16_t* base = O;
        float sc = 1.f; if (split_cols) { const int t = colt / split_cols; base += (size_t)t * split_stride; colt -= t * split_cols; if (t == 0) sc = scale0; }
        const int col0 = colt + wc * 32 + 8 * fq, bcol0 = u.pn * BM + wc * 32 + 8 * fq;
        f32x4 bv[2][2];
#pragma unroll
        for (int bj = 0; bj < 2; ++bj)
#pragma unroll
            for (int n = 0; n < 2; ++n) bv[bj][n] = bias ? *(const f32x4*)(bias + bcol0 + bj * HALF + 4 * n) : (f32x4){0.f, 0.f, 0.f, 0.f};
#pragma unroll
        for (int ai = 0; ai < 2; ++ai)
#pragma unroll
            for (int m = 0; m < 4; ++m) { bf16_t* rowp = base + (size_t)(row0 + ai * HALF + m * 16) * ldc + col0;
#pragma unroll
                for (int bj = 0; bj < 2; ++bj) { f32x4 v0 = acc[ai][bj][m][0] + bv[bj][0], v1 = acc[ai][bj][m][1] + bv[bj][1];
                    if (ACT == 1) { f32x2 a = gelu_pk((f32x2){v0[0], v0[1]}), b = gelu_pk((f32x2){v0[2], v0[3]}), c = gelu_pk((f32x2){v1[0], v1[1]}), d = gelu_pk((f32x2){v1[2], v1[3]});
                        v0 = (f32x4){a.x, a.y, b.x, b.y}; v1 = (f32x4){c.x, c.y, d.x, d.y}; }
                    v0 = v0 * sc; v1 = v1 * sc; u32x4 w; w.x = cvt_pk_bf16(v0[0], v0[1]); w.y = cvt_pk_bf16(v0[2], v0[3]); w.z = cvt_pk_bf16(v1[0], v1[1]); w.w = cvt_pk_bf16(v1[2], v1[3]);
                    *(u32x4*)(rowp + bj * HALF) = w; } }
    }
};
struct EpiF32 {
    static constexpr bool PERM = false, AFTER_DRAIN = false;
    float* O; int ldc;
    __device__ __forceinline__ void operator()(const f32x4 (&acc)[2][2][4][2], const Unit& u, int wr, int wc, int fr, int fq) const {
        const int col0 = u.pn * BM + wc * 32 + 4 * fq;
#pragma unroll
        for (int ai = 0; ai < 2; ++ai)
#pragma unroll
            for (int m = 0; m < 4; ++m) { const int r = ai * HALF + wr * 64 + m * 16 + fr; float* rowp = O + (size_t)(u.pm * BM + r) * ldc + col0;
#pragma unroll
                for (int bj = 0; bj < 2; ++bj)
#pragma unroll
                    for (int n = 0; n < 2; ++n) *(f32x4*)(rowp + bj * HALF + n * 16) = acc[ai][bj][m][n]; }
    }
};
template <class Epi, class Sched, bool ALIGN_EPI = false, bool SP2 = false>
__device__ __forceinline__ void gemm_phase(PG8_LAS unsigned char* lds, const Gemm g, const Sched& S, const Epi& E) {
    const int tid = threadIdx.x, wid = __builtin_amdgcn_readfirstlane(tid >> 6), lane = tid & 63, wr = wid >> 2, wc = wid & 3, fr = lane & 15, fq = lane >> 4;
    const int K = g.K, nt = K / BK;
    unsigned voffA[2], voffB[2];
#pragma unroll
    for (int i = 0; i < 2; ++i) { int R, C; stage_rc(tid * 16 + i * 8192, R, C); const int Rb = Epi::PERM ? ((R & ~31) + perm32(R & 31)) : R;
        voffA[i] = (unsigned)(R * K + C) * 2u; voffB[i] = (unsigned)(Rb * K + C) * 2u; }
    const size_t kstep = (size_t)(BK * 2);
    const size_t hstep = (size_t)HALF * K * 2;
    const size_t tstep = 2 * hstep;
    const unsigned ldsw = (unsigned)wid * 1024u;
    const int aoff = lds_byte(wr * 64 + fr, fq * 8), boff = lds_byte(wc * 32 + fr, fq * 8);
#define PG8_SA(b, h) (((b) * 2 + (h)) * HTB)
#define PG8_SB(b, h) ((4 + (b) * 2 + (h)) * HTB)
#define PG8_STAGE(bufoff, gbase, voff) do { _Pragma("unroll") for (int _i = 0; _i < 2; ++_i) \
        __builtin_amdgcn_global_load_lds((const unsigned*)((const char*)(gbase) + (voff)[_i]), (PG8_LAS unsigned*)(lds + (bufoff) + ldsw + _i * 8192), 16, 0, 0); } while (0)
#define PG8_LDA(dst, b, h) do { _Pragma("unroll") for (int m = 0; m < 4; ++m) _Pragma("unroll") for (int k = 0; k < 2; ++k) dst[m][k] = *(const PG8_LAS bf16x8*)(lds + PG8_SA(b, h) + aoff + m * 2048 + k * 1024); } while (0)
#define PG8_LDB(dst, b, h) do { _Pragma("unroll") for (int n = 0; n < 2; ++n) _Pragma("unroll") for (int k = 0; k < 2; ++k) dst[n][k] = *(const PG8_LAS bf16x8*)(lds + PG8_SB(b, h) + boff + n * 2048 + k * 1024); } while (0)
#define PG8_MMA(ai, bj, At, Bt) do { __builtin_amdgcn_s_setprio(1); _Pragma("unroll") for (int m = 0; m < 4; ++m) _Pragma("unroll") for (int n = 0; n < 2; ++n) _Pragma("unroll") for (int k = 0; k < 2; ++k) \
        acc[ai][bj][m][n] = __builtin_amdgcn_mfma_f32_16x16x32_bf16(Bt[n][k], At[m][k], acc[ai][bj][m][n], 0, 0, 0); __builtin_amdgcn_s_setprio(0); } while (0)
#define PG8_WAIT_V(n) asm volatile("s_waitcnt vmcnt(" #n ")" ::: "memory")
#define PG8_WAIT_L(n) asm volatile("s_waitcnt lgkmcnt(" #n ")" ::: "memory")
#define PG8_BAR __builtin_amdgcn_s_barrier()
#define PG8_SCHED __builtin_amdgcn_sched_barrier(0)
    Unit cur, nxt; int ui = 0;
    if (!S.next(0, cur)) return;
    f32x4 acc[2][2][4][2];
#pragma unroll
    for (int a = 0; a < 2; ++a)
#pragma unroll
        for (int b = 0; b < 2; ++b)
#pragma unroll
            for (int m = 0; m < 4; ++m)
#pragma unroll
                for (int n = 0; n < 2; ++n) acc[a][b][m][n] = (f32x4){0.f, 0.f, 0.f, 0.f};
    bf16x8 At[4][2], B0[2][2], B1[2][2];
    const char* cA = (const char*)g.A + (size_t)cur.pm * tstep; const char* cB = (const char*)g.Bt + (size_t)cur.pn * tstep;
    S.a_ready(cur);
    if constexpr (SP2) {
        PG8_STAGE(PG8_SB(0, 0), cB, voffB); PG8_STAGE(PG8_SB(0, 1), cB + hstep, voffB); PG8_STAGE(PG8_SA(0, 0), cA, voffA); PG8_STAGE(PG8_SA(0, 1), cA + hstep, voffA);
        if (wr == 1) PG8_BAR;
        PG8_WAIT_V(2); PG8_BAR;
        PG8_STAGE(PG8_SB(1, 0), cB + kstep, voffB); PG8_STAGE(PG8_SA(1, 0), cA + kstep, voffA); PG8_STAGE(PG8_SB(1, 1), cB + hstep + kstep, voffB);
        PG8_WAIT_V(6); PG8_BAR;
    } else {
        PG8_STAGE(PG8_SB(0, 0), cB, voffB); PG8_STAGE(PG8_SA(0, 0), cA, voffA); PG8_STAGE(PG8_SB(0, 1), cB + hstep, voffB); PG8_STAGE(PG8_SA(0, 1), cA + hstep, voffA);
        if (wr == 1) PG8_BAR;
        PG8_WAIT_V(4); PG8_BAR;
        PG8_STAGE(PG8_SB(1, 0), cB + kstep, voffB); PG8_STAGE(PG8_SA(1, 0), cA + kstep, voffA); PG8_STAGE(PG8_SB(1, 1), cB + hstep + kstep, voffB);
        PG8_WAIT_V(6); PG8_BAR;
    }
    for (;;) {
        const bool has_next = S.next(ui + 1, nxt);
        const char* nA = has_next ? (const char*)g.A + (size_t)nxt.pm * tstep : cA; const char* nB = has_next ? (const char*)g.Bt + (size_t)nxt.pn * tstep : cB;
        for (int t = 0; t < nt; t += 2) {
            const bool last = (t == nt - 2);
            const char* a1 = cA + (size_t)(t + 1) * kstep;
            const char* a2 = last ? nA : cA + (size_t)(t + 2) * kstep; const char* b2 = last ? nB : cB + (size_t)(t + 2) * kstep;
            const char* a3 = a2 + kstep; const char* b3 = b2 + kstep;
            if (last && has_next) S.a_ready(nxt);
            if constexpr (SP2) {
            PG8_LDB(B0, 0, 0); PG8_LDB(B1, 0, 1); PG8_SCHED; PG8_LDA(At, 0, 0); PG8_STAGE(PG8_SA(1, 1), a1 + hstep, voffA);
            PG8_WAIT_V(8); PG8_WAIT_L(0); PG8_BAR; PG8_MMA(0, 0, At, B0); PG8_MMA(0, 1, At, B1); PG8_BAR; PG8_SCHED;
            PG8_LDA(At, 0, 1); PG8_STAGE(PG8_SB(0, 0), b2, voffB); PG8_STAGE(PG8_SB(0, 1), b2 + hstep, voffB); PG8_STAGE(PG8_SA(0, 0), a2, voffA);
            PG8_WAIT_V(8); PG8_WAIT_L(0); PG8_BAR; PG8_MMA(1, 0, At, B0); PG8_MMA(1, 1, At, B1); PG8_BAR; PG8_SCHED;
            PG8_LDB(B0, 1, 0); PG8_LDB(B1, 1, 1); PG8_SCHED; PG8_LDA(At, 1, 0); PG8_STAGE(PG8_SA(0, 1), a2 + hstep, voffA);
            PG8_WAIT_V(8); PG8_WAIT_L(0); PG8_BAR; PG8_MMA(0, 0, At, B0); PG8_MMA(0, 1, At, B1); PG8_BAR; PG8_SCHED;
            PG8_LDA(At, 1, 1); PG8_STAGE(PG8_SB(1, 0), b3, voffB); PG8_STAGE(PG8_SB(1, 1), b3 + hstep, voffB); PG8_STAGE(PG8_SA(1, 0), a3, voffA);
            PG8_WAIT_V(8); PG8_WAIT_L(0); PG8_BAR; PG8_MMA(1, 0, At, B0); PG8_MMA(1, 1, At, B1); PG8_BAR; PG8_SCHED;
            } else {
            PG8_LDB(B0, 0, 0); PG8_SCHED; PG8_LDA(At, 0, 0); PG8_STAGE(PG8_SA(1, 1), a1 + hstep, voffA);
            PG8_WAIT_L(8); PG8_BAR; PG8_WAIT_L(0); PG8_MMA(0, 0, At, B0); PG8_BAR; PG8_SCHED;
            PG8_LDB(B1, 0, 1); PG8_STAGE(PG8_SB(0, 0), b2, voffB);
            PG8_BAR; PG8_WAIT_L(0); PG8_MMA(0, 1, At, B1); PG8_BAR;
            PG8_LDA(At, 0, 1); PG8_STAGE(PG8_SA(0, 0), a2, voffA);
            PG8_BAR; PG8_WAIT_L(0); PG8_MMA(1, 0, At, B0); PG8_BAR; PG8_SCHED;
            PG8_STAGE(PG8_SB(0, 1), b2 + hstep, voffB);
            PG8_WAIT_V(6); PG8_BAR; PG8_MMA(1, 1, At, B1); PG8_BAR;
            PG8_LDB(B0, 1, 0); PG8_SCHED; PG8_LDA(At, 1, 0); PG8_STAGE(PG8_SA(0, 1), a2 + hstep, voffA);
            PG8_WAIT_L(8); PG8_BAR; PG8_WAIT_L(0); PG8_MMA(0, 0, At, B0); PG8_BAR; PG8_SCHED;
            PG8_LDB(B1, 1, 1); PG8_STAGE(PG8_SB(1, 0), b3, voffB);
            PG8_BAR; PG8_WAIT_L(0); PG8_MMA(0, 1, At, B1); PG8_BAR;
            PG8_LDA(At, 1, 1); PG8_STAGE(PG8_SA(1, 0), a3, voffA);
            PG8_BAR; PG8_WAIT_L(0); PG8_MMA(1, 0, At, B0); PG8_BAR; PG8_SCHED;
            PG8_STAGE(PG8_SB(1, 1), b3 + hstep, voffB);
            PG8_WAIT_V(6); PG8_BAR; PG8_MMA(1, 1, At, B1); PG8_BAR;
            }
        }
        if constexpr (ALIGN_EPI) { if (wr == 0) PG8_BAR; }
        if constexpr (!Epi::AFTER_DRAIN) { E(acc, cur, wr, wc, fr, fq); S.done(cur); }
        if (!has_next) break;
#pragma unroll
        for (int a = 0; a < 2; ++a)
#pragma unroll
            for (int b = 0; b < 2; ++b)
#pragma unroll
                for (int m = 0; m < 4; ++m)
#pragma unroll
                    for (int n = 0; n < 2; ++n) acc[a][b][m][n] = (f32x4){0.f, 0.f, 0.f, 0.f};
        cur = nxt; cA = nA; cB = nB; ++ui;
        if constexpr (ALIGN_EPI) { if (wr == 1) PG8_BAR; }
    }
    PG8_WAIT_V(0);
    if constexpr (!ALIGN_EPI) { if (wr == 0) PG8_BAR; }
    PG8_BAR;
    if constexpr (Epi::AFTER_DRAIN) { E.fused(acc, cur, wr, wc, fr, fq, lds, wid, lane); S.done(cur); }
#undef PG8_SA
#undef PG8_SB
#undef PG8_STAGE
#undef PG8_LDA
#undef PG8_LDB
#undef PG8_MMA
#undef PG8_WAIT_V
#undef PG8_WAIT_L
#undef PG8_BAR
#undef PG8_SCHED
}
}

constexpr int BATCH = 32, SEQ = 2048, DM = 1024, M = BATCH * SEQ;
constexpr int DIN = 4104, NU = 4096;
constexpr int NMEM = 256, MMEM = BATCH * NMEM;
constexpr int UQM = 0, UKM = 512, UVM = 1024, UOM = 1536, UZM = 2048, UQS = 2560, UKS = 2816, UVS = 3072, UZS = 3328, UQC = 3584, UZC = 3840;
constexpr int WIF = 2560;
constexpr float EPS = 1e-6f;
constexpr int YM = 0, YS = 512, YC = 768;

constexpr size_t MiB = 1u << 20;
constexpr size_t WS_CTL = 0, CTL_ZERO_BYTES = 1 * MiB;
constexpr size_t WS_WIN = 2 * MiB;
constexpr size_t WS_WO = 10 * MiB;
constexpr size_t WS_WKV = 12 * MiB;
constexpr size_t WS_G = 14 * MiB;
constexpr size_t WS_MEMN = 16 * MiB;
constexpr size_t WS_KVM = 32 * MiB;
constexpr size_t WS_XN = 64 * MiB;
constexpr size_t WS_Y = 64 * MiB;
constexpr size_t WS_U = 192 * MiB;
constexpr size_t WS_END = 704 * MiB;

typedef unsigned short bf16;
typedef float f32x4 __attribute__((ext_vector_type(4)));
typedef unsigned v4u __attribute__((ext_vector_type(4)));
typedef unsigned v2u __attribute__((ext_vector_type(2)));
#define LAS __attribute__((address_space(3)))

__device__ __forceinline__ unsigned f2bf(float f) { unsigned u = __builtin_bit_cast(unsigned, f); return (u + 0x7fffu + ((u >> 16) & 1u)) >> 16; }
__device__ __forceinline__ unsigned pk2(float lo, float hi) { return f2bf(lo) | (f2bf(hi) << 16); }
__device__ __forceinline__ float bf2f(unsigned h) { return __builtin_bit_cast(float, h << 16); }
__device__ __forceinline__ float bflo(unsigned w) { return __builtin_bit_cast(float, w << 16); }
__device__ __forceinline__ float bfhi(unsigned w) { return __builtin_bit_cast(float, w & 0xffff0000u); }
__device__ __forceinline__ float wave_sum(float v) {
#pragma unroll
    for (int o = 1; o < 64; o <<= 1) v += __shfl_xor(v, o);
    return v;
}
__device__ __forceinline__ float sigmoidf_(float x) { return 1.f / (1.f + __expf(-x)); }
__device__ __forceinline__ float siluf_(float x) { return x / (1.f + __expf(-x)); }

__device__ __forceinline__ void transpose_item(const float* W, int Nsrc, int K, bf16* WT, const float* gk, float* scr, int kb, int n0_dst, int n0_src, int lane) {
    const int k0 = 64 * kb;
#pragma unroll 8
    for (int i = 0; i < 32; ++i) { const int kk = 2 * i + (lane >> 5); const float g = gk ? gk[k0 + kk] : 1.f; scr[kk * 33 + (lane & 31)] = g * W[(size_t)(k0 + kk) * Nsrc + n0_src + (lane & 31)]; }
    __builtin_amdgcn_s_waitcnt(0xC07F); asm volatile("" ::: "memory");
    const int c = lane & 7;
#pragma unroll
    for (int j = 0; j < 4; ++j) { const int n = (lane >> 3) + 8 * j; const float* s = scr + (8 * c) * 33 + n;
        v4u o; o.x = pk2(s[0 * 33], s[1 * 33]); o.y = pk2(s[2 * 33], s[3 * 33]); o.z = pk2(s[4 * 33], s[5 * 33]); o.w = pk2(s[6 * 33], s[7 * 33]);
        *(v4u*)(WT + (size_t)(n0_dst + n) * K + k0 + 8 * c) = o; }
    __builtin_amdgcn_s_waitcnt(0xC07F); asm volatile("" ::: "memory");
}

struct ProArgs {
    const float *x, *mem, *g_pre, *w_in, *i_bias, *f_bias, *g_mem, *w_mem_kv, *w_out;
    bf16 *WIN, *WO, *WKV, *XN, *MEMN; float* G;
};

template <bool GATES>
__device__ __forceinline__ void row_item(const float* xrow, bf16* orow, float* grow, const float* wif, const float* i_bias, const float* f_bias, int h_unused, int lane) {
    const f32x4* xr = (const f32x4*)xrow + lane;
    f32x4 v[4]; float s = 0.f;
#pragma unroll
    for (int j = 0; j < 4; ++j) { v[j] = xr[64 * j]; s += (v[j].x * v[j].x + v[j].y * v[j].y) + (v[j].z * v[j].z + v[j].w * v[j].w); }
    const float rstd = 1.f / sqrtf(wave_sum(s) * (1.f / DM) + EPS);
#pragma unroll
    for (int j = 0; j < 4; ++j) v[j] = v[j] * rstd;
    unsigned long long* o8 = (unsigned long long*)orow + lane;
#pragma unroll
    for (int j = 0; j < 4; ++j) o8[64 * j] = (unsigned long long)pk2(v[j].x, v[j].y) | ((unsigned long long)pk2(v[j].z, v[j].w) << 32);
    if (GATES) {
        float a[8];
#pragma unroll
        for (int g = 0; g < 8; ++g) a[g] = 0.f;
#pragma unroll
        for (int j = 0; j < 4; ++j)
#pragma unroll
            for (int c = 0; c < 4; ++c) { const int k = 4 * (lane + 64 * j) + c; const float xv = v[j][c]; const f32x4 w0 = *(const f32x4*)(wif + k * 8), w1 = *(const f32x4*)(wif + k * 8 + 4);
                a[0] += xv * w0.x; a[1] += xv * w0.y; a[2] += xv * w0.z; a[3] += xv * w0.w; a[4] += xv * w1.x; a[5] += xv * w1.y; a[6] += xv * w1.z; a[7] += xv * w1.w; }
#pragma unroll
        for (int g = 0; g < 8; ++g) a[g] = wave_sum(a[g]);
        float val = a[0];
#pragma unroll
        for (int g = 1; g < 8; ++g) if (lane == g) val = a[g];
        if (lane < 4) grow[lane] = val + i_bias[lane];
        else if (lane < 8) { const float xx = val + f_bias[lane - 4]; grow[lane] = fminf(xx, 0.f) - log1pf(expf(-fabsf(xx))); }
    }
}

__global__ void __launch_bounds__(512) k_prologue(ProArgs a) {
    __shared__ __attribute__((aligned(16))) float sh[8 * 2112 + 8192];
    const int tid = threadIdx.x, lane = tid & 63, wave = tid >> 6;
    float* scr = sh + wave * 2112; float* wif = sh + 8 * 2112;
    for (int i = tid; i < 8192; i += 512) { const int k = i >> 3, g = i & 7; wif[i] = a.g_pre[k] * a.w_in[(size_t)k * DIN + WIF + g]; }
    __syncthreads();
    const int gw = blockIdx.x * 8 + wave, NGW = gridDim.x * 8;
    constexpr int I_IN = 16 * 128, I_O = 16 * 32, I_KV = 16 * 16, NIT = I_IN + I_O + I_KV;
    for (int it = gw; it < NIT; it += NGW) {
        int r = it;
        if (r < I_IN) { const int kb = r / 128, nb = r % 128, n0 = 32 * nb; transpose_item(a.w_in, DIN, DM, a.WIN, a.g_pre, scr, kb, n0, n0 + (n0 >= WIF ? 8 : 0), lane); continue; } r -= I_IN;
        if (r < I_O) { const int kb = r / 32, nb = r % 32; transpose_item(a.w_out, DM, DM, a.WO, nullptr, scr, kb, 32 * nb, 32 * nb, lane); continue; } r -= I_O;
        { const int kb = r / 16, nb = r % 16; transpose_item(a.w_mem_kv, 512, DM, a.WKV, a.g_mem, scr, kb, 32 * nb, 32 * nb, lane); }
    }
    for (int m = gw; m < M; m += NGW) row_item<true>(a.x + (size_t)m * DM, a.XN + (size_t)m * DM, a.G + (size_t)m * 8, wif, a.i_bias, a.f_bias, 0, lane);
    for (int m = gw; m < MMEM; m += NGW) row_item<false>(a.mem + (size_t)m * DM, a.MEMN + (size_t)m * DM, nullptr, wif, nullptr, nullptr, 0, lane);
}

constexpr int GEMM_LDS = 147456;
__global__ void __launch_bounds__(512, 2) k_gemm1(const bf16* XN, const bf16* WIN, bf16* U, const bf16* MEMN, const bf16* WKV, bf16* KVM) {
    extern __shared__ __attribute__((aligned(16))) unsigned char lds[];
    { pg8::Gemm g{XN, WIN, M, NU, DM}; pg8::StaticOrder S; S.init(M, NU, (int)gridDim.x, (int)blockIdx.x);
      pg8::EpiBf16<0> E{U, NU, nullptr, 0, 0, 1.f};
      pg8::gemm_phase<pg8::EpiBf16<0>, pg8::StaticOrder, true, true>((PG8_LAS unsigned char*)lds, g, S, E); }
    { pg8::Gemm g{MEMN, WKV, MMEM, 512, DM}; pg8::StaticOrder S; S.init(MMEM, 512, (int)gridDim.x, (int)blockIdx.x);
      pg8::EpiBf16<0> E{KVM, 512, nullptr, 0, 0, 1.f};
      pg8::gemm_phase<pg8::EpiBf16<0>, pg8::StaticOrder, true, true>((PG8_LAS unsigned char*)lds, g, S, E); }
}
__global__ void __launch_bounds__(512, 2) k_gemm_out(const bf16* Y, const bf16* WO, float* Z) {
    extern __shared__ __attribute__((aligned(16))) unsigned char lds[];
    pg8::Gemm g{Y, WO, M, DM, DM}; pg8::StaticOrder S; S.init(M, DM, (int)gridDim.x, (int)blockIdx.x);
    pg8::EpiF32 E{Z, DM};
    pg8::gemm_phase<pg8::EpiF32, pg8::StaticOrder, true, true>((PG8_LAS unsigned char*)lds, g, S, E);
}

__global__ void __launch_bounds__(192) k_mlstm_naive(const bf16* __restrict__ U, const float* __restrict__ G, const float* __restrict__ conv_w, const float* __restrict__ conv_b,
                                                    const float* __restrict__ g_head, bf16* __restrict__ Y) {
    __shared__ __attribute__((aligned(16))) float qs[16][128], ks[16][128], vs[16][128], s_num[16][128];
    __shared__ float s_den[16], s_fg[16], s_ig[16], s_em[16];
    const int b = blockIdx.x >> 2, h = blockIdx.x & 3, tid = threadIdx.x, lane = tid & 63, wave = tid >> 6;
    const size_t row0 = (size_t)b * SEQ;
    float C[128];
#pragma unroll
    for (int d = 0; d < 128; ++d) C[d] = 0.f;
    float m = 0.f;
    float wq[4], wk[4], bq = 0.f, bk = 0.f;
    const int ce = tid & 127;
#pragma unroll
    for (int j = 0; j < 4; ++j) { wq[j] = conv_w[j * 1024 + h * 128 + ce]; wk[j] = conv_w[j * 1024 + 512 + h * 128 + ce]; }
    bq = conv_b[h * 128 + ce]; bk = conv_b[512 + h * 128 + ce];
    for (int t0 = 0; t0 < SEQ; t0 += 16) {
        if (tid < 128) {
            float uq[19], uk[19];
#pragma unroll
            for (int i = 0; i < 19; ++i) { const int t = t0 - 3 + i;
                if (t >= 0) { uq[i] = bf2f(U[(row0 + t) * NU + UQM + h * 128 + tid]); uk[i] = bf2f(U[(row0 + t) * NU + UKM + h * 128 + tid]); } else { uq[i] = 0.f; uk[i] = 0.f; } }
#pragma unroll
            for (int s = 0; s < 16; ++s) {
                float aq = bq, ak = bk;
#pragma unroll
                for (int j = 0; j < 4; ++j) { aq += wq[j] * uq[s + j]; ak += wk[j] * uk[s + j]; }
                qs[s][tid] = siluf_(aq); ks[s][tid] = siluf_(ak) * 0.08838834764831845f;
                vs[s][tid] = bf2f(U[(row0 + t0 + s) * NU + UVM + h * 128 + tid]);
            }
        } else if (tid == 129) {
#pragma unroll 1
            for (int s = 0; s < 16; ++s) { const float ip = G[(row0 + t0 + s) * 8 + h], lf = G[(row0 + t0 + s) * 8 + 4 + h]; const float mn = fmaxf(lf + m, ip);
                s_fg[s] = expf(lf + m - mn); s_ig[s] = expf(ip - mn); s_em[s] = expf(-mn); m = mn; }
        }
        __syncthreads();
        if (tid <= 128) {
#pragma unroll 1
            for (int s = 0; s < 16; ++s) { const float f = s_fg[s], av = s_ig[s] * (tid < 128 ? vs[s][ce] : 1.f); float num = 0.f;
#pragma unroll
                for (int d = 0; d < 128; d += 4) { const f32x4 k4 = *(const f32x4*)&ks[s][d], q4 = *(const f32x4*)&qs[s][d];
                    C[d] = f * C[d] + av * k4.x; C[d + 1] = f * C[d + 1] + av * k4.y; C[d + 2] = f * C[d + 2] + av * k4.z; C[d + 3] = f * C[d + 3] + av * k4.w;
                    num += C[d] * q4.x + C[d + 1] * q4.y + C[d + 2] * q4.z + C[d + 3] * q4.w; }
                if (tid < 128) s_num[s][tid] = num; else s_den[s] = num; }
        }
        __syncthreads();
        if (wave < 2) {
#pragma unroll 1
            for (int s = wave; s < 16; s += 2) { const float dn = fmaxf(fabsf(s_den[s]), s_em[s]); const float h0 = s_num[s][lane] / dn, h1 = s_num[s][lane + 64] / dn;
                const float ms = wave_sum(h0 * h0 + h1 * h1) * (1.f / 128.f); const float r = 1.f / sqrtf(ms + EPS); const size_t row = row0 + t0 + s;
#pragma unroll
                for (int p = 0; p < 2; ++p) { const int e = lane + 64 * p; const float hh = p ? h1 : h0;
                    const float o = bf2f(U[row * NU + UOM + h * 128 + e]), z = bf2f(U[row * NU + UZM + h * 128 + e]);
                    Y[row * DM + YM + h * 128 + e] = (bf16)f2bf(sigmoidf_(o) * (hh * r * g_head[h * 128 + e]) * siluf_(z)); } }
        }
        __syncthreads();
    }
}

__global__ void __launch_bounds__(64) k_sb_naive(const bf16* __restrict__ U, const float* __restrict__ g_head, bf16* __restrict__ Y) {
    const int tb = blockIdx.x & 31, h = (blockIdx.x >> 5) & 3, b = blockIdx.x >> 7, lane = threadIdx.x, t = tb * 64 + lane;
    const size_t row0 = (size_t)b * SEQ;
    float q[64], acc[64];
    { const v4u* qp = (const v4u*)(U + (row0 + t) * NU + UQS + h * 64);
#pragma unroll
      for (int i = 0; i < 8; ++i) { const v4u w = qp[i]; q[8 * i] = bflo(w.x) * 0.125f; q[8 * i + 1] = bfhi(w.x) * 0.125f; q[8 * i + 2] = bflo(w.y) * 0.125f; q[8 * i + 3] = bfhi(w.y) * 0.125f;
          q[8 * i + 4] = bflo(w.z) * 0.125f; q[8 * i + 5] = bfhi(w.z) * 0.125f; q[8 * i + 6] = bflo(w.w) * 0.125f; q[8 * i + 7] = bfhi(w.w) * 0.125f; } }
#pragma unroll
    for (int d = 0; d < 64; ++d) acc[d] = 0.f;
    float suffix = 0.f;
    for (int s = tb * 64 + 62; s >= 0; --s) {
        const v4u* kp = (const v4u*)(U + (row0 + s) * NU + UKS + h * 64); const v4u* vp = (const v4u*)(U + (row0 + s) * NU + UVS + h * 64);
        float z = 0.f;
#pragma unroll
        for (int i = 0; i < 8; ++i) { const v4u w = kp[i]; z += q[8 * i] * bflo(w.x) + q[8 * i + 1] * bfhi(w.x) + q[8 * i + 2] * bflo(w.y) + q[8 * i + 3] * bfhi(w.y)
                                                         + q[8 * i + 4] * bflo(w.z) + q[8 * i + 5] * bfhi(w.z) + q[8 * i + 6] * bflo(w.w) + q[8 * i + 7] * bfhi(w.w); }
        if (s < t) {
            const float sp = fmaxf(z, 0.f) + log1pf(expf(-fabsf(z)));
            const float a = expf(z - sp - suffix); suffix += sp;
#pragma unroll
            for (int i = 0; i < 8; ++i) { const v4u w = vp[i]; acc[8 * i] += a * bflo(w.x); acc[8 * i + 1] += a * bfhi(w.x); acc[8 * i + 2] += a * bflo(w.y); acc[8 * i + 3] += a * bfhi(w.y);
                acc[8 * i + 4] += a * bflo(w.z); acc[8 * i + 5] += a * bfhi(w.z); acc[8 * i + 6] += a * bflo(w.w); acc[8 * i + 7] += a * bfhi(w.w); }
        }
    }
    float ss = 0.f;
#pragma unroll
    for (int d = 0; d < 64; ++d) ss += acc[d] * acc[d];
    const float r = 1.f / sqrtf(ss * (1.f / 64.f) + EPS);
    const bf16* zp = U + (row0 + t) * NU + UZS + h * 64; bf16* yp = Y + (row0 + t) * DM + YS + h * 64;
#pragma unroll
    for (int d = 0; d < 64; ++d) yp[d] = (bf16)f2bf(acc[d] * r * g_head[h * 64 + d] * siluf_(bf2f(zp[d])));
}

__global__ void __launch_bounds__(64) k_mem_naive(const bf16* __restrict__ U, const bf16* __restrict__ KVM, const float* __restrict__ g_head, bf16* __restrict__ Y) {
    const int tb = blockIdx.x & 31, h = (blockIdx.x >> 5) & 3, b = blockIdx.x >> 7, lane = threadIdx.x, t = tb * 64 + lane;
    const size_t row0 = (size_t)b * SEQ;
    float q[64], acc[64];
    { const v4u* qp = (const v4u*)(U + (row0 + t) * NU + UQC + h * 64);
#pragma unroll
      for (int i = 0; i < 8; ++i) { const v4u w = qp[i]; q[8 * i] = bflo(w.x) * 0.125f; q[8 * i + 1] = bfhi(w.x) * 0.125f; q[8 * i + 2] = bflo(w.y) * 0.125f; q[8 * i + 3] = bfhi(w.y) * 0.125f;
          q[8 * i + 4] = bflo(w.z) * 0.125f; q[8 * i + 5] = bfhi(w.z) * 0.125f; q[8 * i + 6] = bflo(w.w) * 0.125f; q[8 * i + 7] = bfhi(w.w) * 0.125f; } }
#pragma unroll
    for (int d = 0; d < 64; ++d) acc[d] = 0.f;
    float mrun = -1e30f, l = 0.f;
    for (int j = 0; j < NMEM; ++j) {
        const v4u* kp = (const v4u*)(KVM + (size_t)(b * NMEM + j) * 512 + h * 64); const v4u* vp = (const v4u*)(KVM + (size_t)(b * NMEM + j) * 512 + 256 + h * 64);
        float z = 0.f;
#pragma unroll
        for (int i = 0; i < 8; ++i) { const v4u w = kp[i]; z += q[8 * i] * bflo(w.x) + q[8 * i + 1] * bfhi(w.x) + q[8 * i + 2] * bflo(w.y) + q[8 * i + 3] * bfhi(w.y)
                                                         + q[8 * i + 4] * bflo(w.z) + q[8 * i + 5] * bfhi(w.z) + q[8 * i + 6] * bflo(w.w) + q[8 * i + 7] * bfhi(w.w); }
        const float mn = fmaxf(mrun, z), corr = expf(mrun - mn), p = expf(z - mn); mrun = mn; l = l * corr + p;
#pragma unroll
        for (int i = 0; i < 8; ++i) { const v4u w = vp[i]; acc[8 * i] = acc[8 * i] * corr + p * bflo(w.x); acc[8 * i + 1] = acc[8 * i + 1] * corr + p * bfhi(w.x);
            acc[8 * i + 2] = acc[8 * i + 2] * corr + p * bflo(w.y); acc[8 * i + 3] = acc[8 * i + 3] * corr + p * bfhi(w.y);
            acc[8 * i + 4] = acc[8 * i + 4] * corr + p * bflo(w.z); acc[8 * i + 5] = acc[8 * i + 5] * corr + p * bfhi(w.z);
            acc[8 * i + 6] = acc[8 * i + 6] * corr + p * bflo(w.w); acc[8 * i + 7] = acc[8 * i + 7] * corr + p * bfhi(w.w); }
    }
    const float il = 1.f / l; float ss = 0.f;
#pragma unroll
    for (int d = 0; d < 64; ++d) { acc[d] *= il; ss += acc[d] * acc[d]; }
    const float r = 1.f / sqrtf(ss * (1.f / 64.f) + EPS);
    const bf16* zp = U + (row0 + t) * NU + UZC + h * 64; bf16* yp = Y + (row0 + t) * DM + YC + h * 64;
#pragma unroll
    for (int d = 0; d < 64; ++d) yp[d] = (bf16)f2bf(acc[d] * r * g_head[h * 64 + d] * siluf_(bf2f(zp[d])));
}

__global__ void __launch_bounds__(256) k_final(const float* __restrict__ x, const float* __restrict__ g_post, float* out) {
    const int lane = threadIdx.x & 63, gw = blockIdx.x * 4 + (threadIdx.x >> 6), NGW = gridDim.x * 4;
    for (int m = gw; m < M; m += NGW) {
        const f32x4* zr = (const f32x4*)(out + (size_t)m * DM) + lane; const f32x4* xr = (const f32x4*)(x + (size_t)m * DM) + lane; const f32x4* gr = (const f32x4*)g_post + lane;
        f32x4 v[4]; float s = 0.f;
#pragma unroll
        for (int j = 0; j < 4; ++j) { v[j] = zr[64 * j]; s += (v[j].x * v[j].x + v[j].y * v[j].y) + (v[j].z * v[j].z + v[j].w * v[j].w); }
        const float rstd = 1.f / sqrtf(wave_sum(s) * (1.f / DM) + EPS);
        f32x4* orow = (f32x4*)(out + (size_t)m * DM) + lane;
#pragma unroll
        for (int j = 0; j < 4; ++j) orow[64 * j] = xr[64 * j] + v[j] * rstd * gr[64 * j];
    }
}

extern "C" void kernel_launch(void* const* d_in, const int* in_sizes, int n_in, void* d_out, int out_size, void* d_ws, size_t ws_size, hipStream_t stream) {
    if (n_in != 15 || out_size != M * DM || ws_size < WS_END) { fprintf(stderr, "kernel_launch: unexpected shapes (n_in %d out %d ws %zu)\n", n_in, out_size, ws_size); return; }
    const float* x = (const float*)d_in[0]; const float* mem = (const float*)d_in[1]; const float* g_pre = (const float*)d_in[2]; const float* w_in = (const float*)d_in[3];
    const float* conv_w = (const float*)d_in[4]; const float* conv_b = (const float*)d_in[5]; const float* i_bias = (const float*)d_in[6]; const float* f_bias = (const float*)d_in[7];
    const float* g_mh = (const float*)d_in[8]; const float* g_sh = (const float*)d_in[9]; const float* g_ch = (const float*)d_in[10]; const float* g_mem = (const float*)d_in[11];
    const float* w_kv = (const float*)d_in[12]; const float* w_out = (const float*)d_in[13]; const float* g_post = (const float*)d_in[14];
    unsigned char* ws = (unsigned char*)d_ws; float* out = (float*)d_out;
    bf16* WIN = (bf16*)(ws + WS_WIN); bf16* WO = (bf16*)(ws + WS_WO); bf16* WKV = (bf16*)(ws + WS_WKV); float* G = (float*)(ws + WS_G);
    bf16* MEMN = (bf16*)(ws + WS_MEMN); bf16* KVM = (bf16*)(ws + WS_KVM); bf16* XN = (bf16*)(ws + WS_XN); bf16* Y = (bf16*)(ws + WS_Y); bf16* U = (bf16*)(ws + WS_U);
    (void)hipFuncSetAttribute((const void*)k_gemm1, hipFuncAttributeMaxDynamicSharedMemorySize, GEMM_LDS);
    (void)hipFuncSetAttribute((const void*)k_gemm_out, hipFuncAttributeMaxDynamicSharedMemorySize, GEMM_LDS);
    ProArgs pa{x, mem, g_pre, w_in, i_bias, f_bias, g_mem, w_kv, w_out, WIN, WO, WKV, XN, MEMN, G};
    hipLaunchKernelGGL(k_prologue, dim3(1024), dim3(512), 0, stream, pa);
    hipLaunchKernelGGL(k_gemm1, dim3(256), dim3(512), GEMM_LDS, stream, XN, WIN, U, MEMN, WKV, KVM);
    hipLaunchKernelGGL(k_mlstm_naive, dim3(128), dim3(192), 0, stream, U, G, conv_w, conv_b, g_mh, Y);
    hipLaunchKernelGGL(k_sb_naive, dim3(4096), dim3(64), 0, stream, U, g_sh, Y);
    hipLaunchKernelGGL(k_mem_naive, dim3(4096), dim3(64), 0, stream, U, KVM, g_ch, Y);
    hipLaunchKernelGGL(k_gemm_out, dim3(256), dim3(512), GEMM_LDS, stream, Y, WO, out);
    hipLaunchKernelGGL(k_final, dim3(2048), dim3(256), 0, stream, x, g_post, out);
}
```

```cpp
#include <hip/hip_runtime.h>
#include <hip/hip_cooperative_groups.h>
#include <cstdio>
#include <cstdint>
namespace cg = cooperative_groups;
namespace pg8 {
#define PG8_LAS __attribute__((address_space(3)))
typedef unsigned short bf16_t;
typedef short bf16x8 __attribute__((ext_vector_type(8)));
typedef float f32x4 __attribute__((ext_vector_type(4)));
typedef unsigned u32x4 __attribute__((ext_vector_type(4)));
constexpr int BM = 256, BK = 64, HALF = 128, HTB = HALF * BK * 2  , STAGE_BYTES = 8 * HTB, NXCD = 8, WGM = 8;

__host__ __device__ __forceinline__ int lds_byte(int r, int c) { const int st = (r >> 4) * 2 + (c >> 5), rr = r & 15, cc = c & 31, ob = rr * 64 + cc * 2; return st * 1024 + (ob ^ (((ob >> 9) & 1) << 5)); }
__host__ __device__ __forceinline__ void stage_rc(int b, int& R, int& C) { const int st = b / 1024, sb = b % 1024, swz = sb ^ (((sb >> 9) & 1) << 5); R = (st >> 1) * 16 + swz / 64; C = (st & 1) * 32 + (swz % 64) / 2; }
__host__ __device__ __forceinline__ int perm32(int rho) { const int n = rho >> 4, i = rho & 15; return 8 * (i >> 2) + 4 * n + (i & 3); }

struct Unit { int pm, pn; };
struct Gemm { const bf16_t* A; const bf16_t* Bt; int M, N, K; };

struct StaticOrder {
    int nM, nN, nwg, G, c;
    __host__ __device__ void init(int M, int N, int G_, int c_) { nM = M / BM; nN = N / BM; nwg = nM * nN; G = G_; c = c_; }
    __host__ __device__ bool next(int i, Unit& u) const {
        const long L = (long)i * G + c; if (L >= nwg) return false;
        int wgid = (int)L; { const int q = nwg / NXCD, r = nwg % NXCD, xcd = wgid % NXCD, off = wgid / NXCD; wgid = (xcd < r ? xcd * (q + 1) : r * (q + 1) + (xcd - r) * q) + off; }
        const int nig = WGM * nN, gid = wgid / nig, fm = gid * WGM, gsz = (nM - fm) < WGM ? (nM - fm) : WGM;
        u.pm = fm + ((wgid % nig) % gsz); u.pn = (wgid % nig) / gsz; return true;
    }
    __device__ __forceinline__ void a_ready(const Unit&) const {}
    __device__ __forceinline__ void done(const Unit&) const {}
};

__device__ __forceinline__ unsigned cvt_pk_bf16(float lo, float hi) { unsigned r; asm volatile("v_cvt_pk_bf16_f32 %0, %1, %2" : "=v"(r) : "v"(lo), "v"(hi)); return r; }
typedef float f32x2 __attribute__((ext_vector_type(2)));
__device__ __forceinline__ f32x2 gelu_pk(f32x2 v) {
    const f32x2 av = __builtin_elementwise_abs(v), d = av * 0.2316418882f + 1.0f;
    f32x2 t; t.x = __builtin_amdgcn_rcpf(d.x); t.y = __builtin_amdgcn_rcpf(d.y);
    f32x2 q = t * 0.5307027145f + (-0.7265760135f); q = q * t + 0.7107068705f; q = q * t + (-0.142248368f); q = q * t + 0.127414796f; q = q * t;
    const f32x2 s = (v * v) * (-0.72134752044f);
    f32x2 e; e.x = __builtin_amdgcn_exp2f(s.x); e.y = __builtin_amdgcn_exp2f(s.y);
    const f32x2 m = v * (q * e), r = v - m;
    f32x2 o; o.x = v.x < 0.f ? m.x : r.x; o.y = v.y < 0.f ? m.y : r.y; return o;
}

template <int ACT  > struct EpiBf16 {
    static constexpr bool PERM = true, AFTER_DRAIN = false; static_assert(ACT == 0 || ACT == 1, "EpiBf16: ACT is 0 (none) or 1 (gelu_pk)");
    bf16_t* O; int ldc; const float* bias; int split_cols; size_t split_stride; float scale0;
    __device__ __forceinline__ void operator()(const f32x4 (&acc)[2][2][4][2], const Unit& u, int wr, int wc, int fr, int fq) const {
        const int row0 = u.pm * BM + wr * 64 + fr; int colt = u.pn * BM; bf16_t* base = O;
        float sc = 1.f; if (split_cols) { const int t = colt / split_cols; base += (size_t)t * split_stride; colt -= t * split_cols; if (t == 0) sc = scale0; }
        const int col0 = colt + wc * 32 + 8 * fq, bcol0 = u.pn * BM + wc * 32 + 8 * fq;
        f32x4 bv[2][2];
#pragma unroll
        for (int bj = 0; bj < 2; ++bj)
#pragma unroll
            for (int n = 0; n < 2; ++n) bv[bj][n] = bias ? *(const f32x4*)(bias + bcol0 + bj * HALF + 4 * n) : (f32x4){0.f, 0.f, 0.f, 0.f};
#pragma unroll
        for (int ai = 0; ai < 2; ++ai)
#pragma unroll
            for (int m = 0; m < 4; ++m) { bf16_t* rowp = base + (size_t)(row0 + ai * HALF + m * 16) * ldc + col0;
#pragma unroll
                for (int bj = 0; bj < 2; ++bj) { f32x4 v0 = acc[ai][bj][m][0] + bv[bj][0], v1 = acc[ai][bj][m][1] + bv[bj][1];
                    if (ACT == 1) { f32x2 a = gelu_pk((f32x2){v0[0], v0[1]}), b = gelu_pk((f32x2){v0[2], v0[3]}), c = gelu_pk((f32x2){v1[0], v1[1]}), d = gelu_pk((f32x2){v1[2], v1[3]});
                        v0 = (f32x4){a.x, a.y, b.x, b.y}; v1 = (f32x4){c.x, c.y, d.x, d.y}; }
                    v0 = v0 * sc; v1 = v1 * sc; u32x4 w; w.x = cvt_pk_bf16(v0[0], v0[1]); w.y = cvt_pk_bf16(v0[2], v0[3]); w.z = cvt_pk_bf16(v1[0], v1[1]); w.w = cvt_pk_bf16(v1[2], v1[3]);
                    *(u32x4*)(rowp + bj * HALF) = w; } }
    }
};
struct EpiF32 {
    static constexpr bool PERM = false, AFTER_DRAIN = false;
    float* O; int ldc;
    __device__ __forceinline__ void operator()(const f32x4 (&acc)[2][2][4][2], const Unit& u, int wr, int wc, int fr, int fq) const {
        const int col0 = u.pn * BM + wc * 32 + 4 * fq;
#pragma unroll
        for (int ai = 0; ai < 2; ++ai)
#pragma unroll
            for (int m = 0; m < 4; ++m) { const int r = ai * HALF + wr * 64 + m * 16 + fr; float* rowp = O + (size_t)(u.pm * BM + r) * ldc + col0;
#pragma unroll
                for (int bj = 0; bj < 2; ++bj)
#pragma unroll
                    for (int n = 0; n < 2; ++n) *(f32x4*)(rowp + bj * HALF + n * 16) = acc[ai][bj][m][n]; }
    }
};
template <class Epi, class Sched, bool ALIGN_EPI = false, bool SP2 = false>
__device__ __forceinline__ void gemm_phase(PG8_LAS unsigned char* lds, const Gemm g, const Sched& S, const Epi& E) {
    const int tid = threadIdx.x, wid = __builtin_amdgcn_readfirstlane(tid >> 6), lane = tid & 63, wr = wid >> 2, wc = wid & 3, fr = lane & 15, fq = lane >> 4;
    const int K = g.K, nt = K / BK;
    unsigned voffA[2], voffB[2];
#pragma unroll
    for (int i = 0; i < 2; ++i) { int R, C; stage_rc(tid * 16 + i * 8192, R, C); const int Rb = Epi::PERM ? ((R & ~31) + perm32(R & 31)) : R;
        voffA[i] = (unsigned)(R * K + C) * 2u; voffB[i] = (unsigned)(Rb * K + C) * 2u; }
    const size_t kstep = (size_t)(BK * 2);
    const size_t hstep = (size_t)HALF * K * 2;
    const size_t tstep = 2 * hstep;
    const unsigned ldsw = (unsigned)wid * 1024u;
    const int aoff = lds_byte(wr * 64 + fr, fq * 8), boff = lds_byte(wc * 32 + fr, fq * 8);
#define PG8_SA(b, h) (((b) * 2 + (h)) * HTB)
#define PG8_SB(b, h) ((4 + (b) * 2 + (h)) * HTB)
#define PG8_STAGE(bufoff, gbase, voff) do { _Pragma("unroll") for (int _i = 0; _i < 2; ++_i) \
        __builtin_amdgcn_global_load_lds((const unsigned*)((const char*)(gbase) + (voff)[_i]), (PG8_LAS unsigned*)(lds + (bufoff) + ldsw + _i * 8192), 16, 0, 0); } while (0)
#define PG8_LDA(dst, b, h) do { _Pragma("unroll") for (int m = 0; m < 4; ++m) _Pragma("unroll") for (int k = 0; k < 2; ++k) dst[m][k] = *(const PG8_LAS bf16x8*)(lds + PG8_SA(b, h) + aoff + m * 2048 + k * 1024); } while (0)
#define PG8_LDB(dst, b, h) do { _Pragma("unroll") for (int n = 0; n < 2; ++n) _Pragma("unroll") for (int k = 0; k < 2; ++k) dst[n][k] = *(const PG8_LAS bf16x8*)(lds + PG8_SB(b, h) + boff + n * 2048 + k * 1024); } while (0)
#define PG8_MMA(ai, bj, At, Bt) do { __builtin_amdgcn_s_setprio(1); _Pragma("unroll") for (int m = 0; m < 4; ++m) _Pragma("unroll") for (int n = 0; n < 2; ++n) _Pragma("unroll") for (int k = 0; k < 2; ++k) \
        acc[ai][bj][m][n] = __builtin_amdgcn_mfma_f32_16x16x32_bf16(Bt[n][k], At[m][k], acc[ai][bj][m][n], 0, 0, 0); __builtin_amdgcn_s_setprio(0); } while (0)
#define PG8_WAIT_V(n) asm volatile("s_waitcnt vmcnt(" #n ")" ::: "memory")
#define PG8_WAIT_L(n) asm volatile("s_waitcnt lgkmcnt(" #n ")" ::: "memory")
#define PG8_BAR __builtin_amdgcn_s_barrier()
#define PG8_SCHED __builtin_amdgcn_sched_barrier(0)
    Unit cur, nxt; int ui = 0;
    if (!S.next(0, cur)) return;
    f32x4 acc[2][2][4][2];
#pragma unroll
    for (int a = 0; a < 2; ++a)
#pragma unroll
        for (int b = 0; b < 2; ++b)
#pragma unroll
            for (int m = 0; m < 4; ++m)
#pragma unroll
                for (int n = 0; n < 2; ++n) acc[a][b][m][n] = (f32x4){0.f, 0.f, 0.f, 0.f};
    bf16x8 At[4][2], B0[2][2], B1[2][2];
    const char* cA = (const char*)g.A + (size_t)cur.pm * tstep; const char* cB = (const char*)g.Bt + (size_t)cur.pn * tstep;
    S.a_ready(cur);
    if constexpr (SP2) {
        PG8_STAGE(PG8_SB(0, 0), cB, voffB); PG8_STAGE(PG8_SB(0, 1), cB + hstep, voffB); PG8_STAGE(PG8_SA(0, 0), cA, voffA); PG8_STAGE(PG8_SA(0, 1), cA + hstep, voffA);
        if (wr == 1) PG8_BAR;
        PG8_WAIT_V(2); PG8_BAR;
        PG8_STAGE(PG8_SB(1, 0), cB + kstep, voffB); PG8_STAGE(PG8_SA(1, 0), cA + kstep, voffA); PG8_STAGE(PG8_SB(1, 1), cB + hstep + kstep, voffB);
        PG8_WAIT_V(6); PG8_BAR;
    } else {
        PG8_STAGE(PG8_SB(0, 0), cB, voffB); PG8_STAGE(PG8_SA(0, 0), cA, voffA); PG8_STAGE(PG8_SB(0, 1), cB + hstep, voffB); PG8_STAGE(PG8_SA(0, 1), cA + hstep, voffA);
        if (wr == 1) PG8_BAR;
        PG8_WAIT_V(4); PG8_BAR;
        PG8_STAGE(PG8_SB(1, 0), cB + kstep, voffB); PG8_STAGE(PG8_SA(1, 0), cA + kstep, voffA); PG8_STAGE(PG8_SB(1, 1), cB + hstep + kstep, voffB);
        PG8_WAIT_V(6); PG8_BAR;
    }
    for (;;) {
        const bool has_next = S.next(ui + 1, nxt);
        const char* nA = has_next ? (const char*)g.A + (size_t)nxt.pm * tstep : cA; const char* nB = has_next ? (const char*)g.Bt + (size_t)nxt.pn * tstep : cB;
        for (int t = 0; t < nt; t += 2) {
            const bool last = (t == nt - 2);
            const char* a1 = cA + (size_t)(t + 1) * kstep;
            const char* a2 = last ? nA : cA + (size_t)(t + 2) * kstep; const char* b2 = last ? nB : cB + (size_t)(t + 2) * kstep;
            const char* a3 = a2 + kstep; const char* b3 = b2 + kstep;
            if (last && has_next) S.a_ready(nxt);
            if constexpr (SP2) {
            PG8_LDB(B0, 0, 0); PG8_LDB(B1, 0, 1); PG8_SCHED; PG8_LDA(At, 0, 0); PG8_STAGE(PG8_SA(1, 1), a1 + hstep, voffA);
            PG8_WAIT_V(8); PG8_WAIT_L(0); PG8_BAR; PG8_MMA(0, 0, At, B0); PG8_MMA(0, 1, At, B1); PG8_BAR; PG8_SCHED;
            PG8_LDA(At, 0, 1); PG8_STAGE(PG8_SB(0, 0), b2, voffB); PG8_STAGE(PG8_SB(0, 1), b2 + hstep, voffB); PG8_STAGE(PG8_SA(0, 0), a2, voffA);
            PG8_WAIT_V(8); PG8_WAIT_L(0); PG8_BAR; PG8_MMA(1, 0, At, B0); PG8_MMA(1, 1, At, B1); PG8_BAR; PG8_SCHED;
            PG8_LDB(B0, 1, 0); PG8_LDB(B1, 1, 1); PG8_SCHED; PG8_LDA(At, 1, 0); PG8_STAGE(PG8_SA(0, 1), a2 + hstep, voffA);
            PG8_WAIT_V(8); PG8_WAIT_L(0); PG8_BAR; PG8_MMA(0, 0, At, B0); PG8_MMA(0, 1, At, B1); PG8_BAR; PG8_SCHED;
            PG8_LDA(At, 1, 1); PG8_STAGE(PG8_SB(1, 0), b3, voffB); PG8_STAGE(PG8_SB(1, 1), b3 + hstep, voffB); PG8_STAGE(PG8_SA(1, 0), a3, voffA);
            PG8_WAIT_V(8); PG8_WAIT_L(0); PG8_BAR; PG8_MMA(1, 0, At, B0); PG8_MMA(1, 1, At, B1); PG8_BAR; PG8_SCHED;
            } else {
            PG8_LDB(B0, 0, 0); PG8_SCHED; PG8_LDA(At, 0, 0); PG8_STAGE(PG8_SA(1, 1), a1 + hstep, voffA);
            PG8_WAIT_L(8); PG8_BAR; PG8_WAIT_L(0); PG8_MMA(0, 0, At, B0); PG8_BAR; PG8_SCHED;
            PG8_LDB(B1, 0, 1); PG8_STAGE(PG8_SB(0, 0), b2, voffB);
            PG8_BAR; PG8_WAIT_L(0); PG8_MMA(0, 1, At, B1); PG8_BAR;
            PG8_LDA(At, 0, 1); PG8_STAGE(PG8_SA(0, 0), a2, voffA);
            PG8_BAR; PG8_WAIT_L(0); PG8_MMA(1, 0, At, B0); PG8_BAR; PG8_SCHED;
            PG8_STAGE(PG8_SB(0, 1), b2 + hstep, voffB);
            PG8_WAIT_V(6); PG8_BAR; PG8_MMA(1, 1, At, B1); PG8_BAR;
            PG8_LDB(B0, 1, 0); PG8_SCHED; PG8_LDA(At, 1, 0); PG8_STAGE(PG8_SA(0, 1), a2 + hstep, voffA);
            PG8_WAIT_L(8); PG8_BAR; PG8_WAIT_L(0); PG8_MMA(0, 0, At, B0); PG8_BAR; PG8_SCHED;
            PG8_LDB(B1, 1, 1); PG8_STAGE(PG8_SB(1, 0), b3, voffB);
            PG8_BAR; PG8_WAIT_L(0); PG8_MMA(0, 1, At, B1); PG8_BAR;
            PG8_LDA(At, 1, 1); PG8_STAGE(PG8_SA(1, 0), a3, voffA);
            PG8_BAR; PG8_WAIT_L(0); PG8_MMA(1, 0, At, B0); PG8_BAR; PG8_SCHED;
            PG8_STAGE(PG8_SB(1, 1), b3 + hstep, voffB);
            PG8_WAIT_V(6); PG8_BAR; PG8_MMA(1, 1, At, B1); PG8_BAR;
            }
        }
        if constexpr (ALIGN_EPI) { if (wr == 0) PG8_BAR; }
        if constexpr (!Epi::AFTER_DRAIN) { E(acc, cur, wr, wc, fr, fq); S.done(cur); }
        if (!has_next) break;
#pragma unroll
        for (int a = 0; a < 2; ++a)
#pragma unroll
            for (int b = 0; b < 2; ++b)
#pragma unroll
                for (int m = 0; m < 4; ++m)
#pragma unroll
                    for (int n = 0; n < 2; ++n) acc[a][b][m][n] = (f32x4){0.f, 0.f, 0.f, 0.f};
        cur = nxt; cA = nA; cB = nB; ++ui;
        if constexpr (ALIGN_EPI) { if (wr == 1) PG8_BAR; }
    }
    PG8_WAIT_V(0);
    if constexpr (!ALIGN_EPI) { if (wr == 0) PG8_BAR; }
    PG8_BAR;
    if constexpr (Epi::AFTER_DRAIN) { E.fused(acc, cur, wr, wc, fr, fq, lds, wid, lane); S.done(cur); }
#undef PG8_SA
#undef PG8_SB
#undef PG8_STAGE
#undef PG8_LDA
#undef PG8_LDB
#undef PG8_MMA
#undef PG8_WAIT_V
#undef PG8_WAIT_L
#undef PG8_BAR
#undef PG8_SCHED
}
}

constexpr int BATCH = 32, SEQ = 2048, DM = 1024, M = BATCH * SEQ;
constexpr int DIN = 4104, NU = 4096;
constexpr int NMEM = 256, MMEM = BATCH * NMEM;
constexpr int UQM = 0, UKM = 512, UVM = 1024, UOM = 1536, UZM = 2048, UQS = 2560, UKS = 2816, UVS = 3072, UZS = 3328, UQC = 3584, UZC = 3840;
constexpr int WIF = 2560;
constexpr float EPS = 1e-6f;
constexpr int YM = 0, YS = 512, YC = 768;

constexpr size_t MiB = 1u << 20;
constexpr size_t WS_CTL = 0, CTL_ZERO_BYTES = 1 * MiB;
constexpr size_t WS_WIN = 2 * MiB;
constexpr size_t WS_WO = 10 * MiB;
constexpr size_t WS_WKV = 12 * MiB;
constexpr size_t WS_G = 14 * MiB;
constexpr size_t WS_MEMN = 16 * MiB;
constexpr size_t WS_KVM = 32 * MiB;
constexpr size_t WS_XN = 64 * MiB;
constexpr size_t WS_Y = 64 * MiB;
constexpr size_t WS_U = 192 * MiB;
constexpr size_t WS_END = 704 * MiB;

typedef unsigned short bf16;
typedef float f32x4 __attribute__((ext_vector_type(4)));
typedef unsigned v4u __attribute__((ext_vector_type(4)));
typedef unsigned v2u __attribute__((ext_vector_type(2)));
#define LAS __attribute__((address_space(3)))

__device__ __forceinline__ unsigned f2bf(float f) { unsigned u = __builtin_bit_cast(unsigned, f); return (u + 0x7fffu + ((u >> 16) & 1u)) >> 16; }
__device__ __forceinline__ unsigned pk2(float lo, float hi) { return f2bf(lo) | (f2bf(hi) << 16); }
__device__ __forceinline__ float bf2f(unsigned h) { return __builtin_bit_cast(float, h << 16); }
__device__ __forceinline__ float bflo(unsigned w) { return __builtin_bit_cast(float, w << 16); }
__device__ __forceinline__ float bfhi(unsigned w) { return __builtin_bit_cast(float, w & 0xffff0000u); }
__device__ __forceinline__ float wave_sum(float v) {
#pragma unroll
    for (int o = 1; o < 64; o <<= 1) v += __shfl_xor(v, o);
    return v;
}
__device__ __forceinline__ float sigmoidf_(float x) { return 1.f / (1.f + __expf(-x)); }
__device__ __forceinline__ float siluf_(float x) { return x / (1.f + __expf(-x)); }

__device__ __forceinline__ void transpose_item(const float* W, int Nsrc, int K, bf16* WT, const float* gk, float* scr, int kb, int n0_dst, int n0_src, int lane) {
    const int k0 = 64 * kb;
#pragma unroll 8
    for (int i = 0; i < 32; ++i) { const int kk = 2 * i + (lane >> 5); const float g = gk ? gk[k0 + kk] : 1.f; scr[kk * 33 + (lane & 31)] = g * W[(size_t)(k0 + kk) * Nsrc + n0_src + (lane & 31)]; }
    __builtin_amdgcn_s_waitcnt(0xC07F); asm volatile("" ::: "memory");
    const int c = lane & 7;
#pragma unroll
    for (int j = 0; j < 4; ++j) { const int n = (lane >> 3) + 8 * j; const float* s = scr + (8 * c) * 33 + n;
        v4u o; o.x = pk2(s[0 * 33], s[1 * 33]); o.y = pk2(s[2 * 33], s[3 * 33]); o.z = pk2(s[4 * 33], s[5 * 33]); o.w = pk2(s[6 * 33], s[7 * 33]);
        *(v4u*)(WT + (size_t)(n0_dst + n) * K + k0 + 8 * c) = o; }
    __builtin_amdgcn_s_waitcnt(0xC07F); asm volatile("" ::: "memory");
}

struct ProArgs {
    const float *x, *mem, *g_pre, *w_in, *i_bias, *f_bias, *g_mem, *w_mem_kv, *w_out;
    bf16 *WIN, *WO, *WKV, *XN, *MEMN; float* G;
};

template <bool GATES>
__device__ __forceinline__ void row_item(const float* xrow, bf16* orow, float* grow, const float* wif, const float* i_bias, const float* f_bias, int h_unused, int lane) {
    const f32x4* xr = (const f32x4*)xrow + lane;
    f32x4 v[4]; float s = 0.f;
#pragma unroll
    for (int j = 0; j < 4; ++j) { v[j] = xr[64 * j]; s += (v[j].x * v[j].x + v[j].y * v[j].y) + (v[j].z * v[j].z + v[j].w * v[j].w); }
    const float rstd = 1.f / sqrtf(wave_sum(s) * (1.f / DM) + EPS);
#pragma unroll
    for (int j = 0; j < 4; ++j) v[j] = v[j] * rstd;
    unsigned long long* o8 = (unsigned long long*)orow + lane;
#pragma unroll
    for (int j = 0; j < 4; ++j) o8[64 * j] = (unsigned long long)pk2(v[j].x, v[j].y) | ((unsigned long long)pk2(v[j].z, v[j].w) << 32);
    if (GATES) {
        float a[8];
#pragma unroll
        for (int g = 0; g < 8; ++g) a[g] = 0.f;
#pragma unroll
        for (int j = 0; j < 4; ++j)
#pragma unroll
            for (int c = 0; c < 4; ++c) { const int k = 4 * (lane + 64 * j) + c; const float xv = v[j][c]; const f32x4 w0 = *(const f32x4*)(wif + k * 8), w1 = *(const f32x4*)(wif + k * 8 + 4);
                a[0] += xv * w0.x; a[1] += xv * w0.y; a[2] += xv * w0.z; a[3] += xv * w0.w; a[4] += xv * w1.x; a[5] += xv * w1.y; a[6] += xv * w1.z; a[7] += xv * w1.w; }
#pragma unroll
        for (int g = 0; g < 8; ++g) a[g] = wave_sum(a[g]);
        float val = a[0];
#pragma unroll
        for (int g = 1; g < 8; ++g) if (lane == g) val = a[g];
        if (lane < 4) grow[lane] = val + i_bias[lane];
        else if (lane < 8) { const float xx = val + f_bias[lane - 4]; grow[lane] = fminf(xx, 0.f) - log1pf(expf(-fabsf(xx))); }
    }
}

__device__ __forceinline__ void phase_prologue(const ProArgs& a, float* sh, int nblocks, int block) {
    const int tid = threadIdx.x, lane = tid & 63, wave = tid >> 6;
    float* scr = sh + wave * 2112; float* wif = sh + 8 * 2112;
    for (int i = tid; i < 8192; i += 512) { const int k = i >> 3, g = i & 7; wif[i] = a.g_pre[k] * a.w_in[(size_t)k * DIN + WIF + g]; }
    __syncthreads();
    const int gw = block * 8 + wave, NGW = nblocks * 8;
    constexpr int I_IN = 16 * 128, I_O = 16 * 32, I_KV = 16 * 16, NIT = I_IN + I_O + I_KV;
    for (int it = gw; it < NIT; it += NGW) {
        int r = it;
        if (r < I_IN) { const int kb = r / 128, nb = r % 128, n0 = 32 * nb; transpose_item(a.w_in, DIN, DM, a.WIN, a.g_pre, scr, kb, n0, n0 + (n0 >= WIF ? 8 : 0), lane); continue; } r -= I_IN;
        if (r < I_O) { const int kb = r / 32, nb = r % 32; transpose_item(a.w_out, DM, DM, a.WO, nullptr, scr, kb, 32 * nb, 32 * nb, lane); continue; } r -= I_O;
        { const int kb = r / 16, nb = r % 16; transpose_item(a.w_mem_kv, 512, DM, a.WKV, a.g_mem, scr, kb, 32 * nb, 32 * nb, lane); }
    }
    for (int m = gw; m < M; m += NGW) row_item<true>(a.x + (size_t)m * DM, a.XN + (size_t)m * DM, a.G + (size_t)m * 8, wif, a.i_bias, a.f_bias, 0, lane);
    for (int m = gw; m < MMEM; m += NGW) row_item<false>(a.mem + (size_t)m * DM, a.MEMN + (size_t)m * DM, nullptr, wif, nullptr, nullptr, 0, lane);
}

__device__ __forceinline__ void mlstm_naive_unit(int b, int h, const bf16* __restrict__ U, const float* __restrict__ G, const float* __restrict__ conv_w, const float* __restrict__ conv_b,
                                                 const float* __restrict__ g_head, bf16* __restrict__ Y, float* shf) {
    float (*qs)[128] = (float (*)[128])shf; float (*ks)[128] = (float (*)[128])(shf + 2048); float (*vs)[128] = (float (*)[128])(shf + 4096); float (*s_num)[128] = (float (*)[128])(shf + 6144);
    float* s_den = shf + 8192; float* s_fg = shf + 8208; float* s_ig = shf + 8224; float* s_em = shf + 8240;
    const int tid = threadIdx.x, lane = tid & 63, wave = tid >> 6;
    const size_t row0 = (size_t)b * SEQ;
    float C[128];
#pragma unroll
    for (int d = 0; d < 128; ++d) C[d] = 0.f;
    float m = 0.f;
    float wq[4], wk[4], bq = 0.f, bk = 0.f;
    const int ce = tid & 127;
#pragma unroll
    for (int j = 0; j < 4; ++j) { wq[j] = conv_w[j * 1024 + h * 128 + ce]; wk[j] = conv_w[j * 1024 + 512 + h * 128 + ce]; }
    bq = conv_b[h * 128 + ce]; bk = conv_b[512 + h * 128 + ce];
    for (int t0 = 0; t0 < SEQ; t0 += 16) {
        if (tid < 128) {
#pragma unroll 1
            for (int s = 0; s < 16; ++s) {
                float aq = bq, ak = bk;
#pragma unroll
                for (int j = 0; j < 4; ++j) { const int t = t0 + s - 3 + j;
                    if (t >= 0) { aq += wq[j] * bf2f(U[(row0 + t) * NU + UQM + h * 128 + tid]); ak += wk[j] * bf2f(U[(row0 + t) * NU + UKM + h * 128 + tid]); } }
                qs[s][tid] = siluf_(aq); ks[s][tid] = siluf_(ak) * 0.08838834764831845f;
                vs[s][tid] = bf2f(U[(row0 + t0 + s) * NU + UVM + h * 128 + tid]);
            }
        } else if (tid == 129) {
#pragma unroll 1
            for (int s = 0; s < 16; ++s) { const float ip = G[(row0 + t0 + s) * 8 + h], lf = G[(row0 + t0 + s) * 8 + 4 + h]; const float mn = fmaxf(lf + m, ip);
                s_fg[s] = expf(lf + m - mn); s_ig[s] = expf(ip - mn); s_em[s] = expf(-mn); m = mn; }
        }
        __syncthreads();
        if (tid <= 128) {
#pragma unroll 1
            for (int s = 0; s < 16; ++s) { const float f = s_fg[s], av = s_ig[s] * (tid < 128 ? vs[s][ce] : 1.f); float num = 0.f;
#pragma unroll
                for (int d = 0; d < 128; d += 4) { const f32x4 k4 = *(const f32x4*)&ks[s][d], q4 = *(const f32x4*)&qs[s][d];
                    C[d] = f * C[d] + av * k4.x; C[d + 1] = f * C[d + 1] + av * k4.y; C[d + 2] = f * C[d + 2] + av * k4.z; C[d + 3] = f * C[d + 3] + av * k4.w;
                    num += C[d] * q4.x + C[d + 1] * q4.y + C[d + 2] * q4.z + C[d + 3] * q4.w; }
                if (tid < 128) s_num[s][tid] = num; else s_den[s] = num; }
        }
        __syncthreads();
        if (wave < 2) {
#pragma unroll 1
            for (int s = wave; s < 16; s += 2) { const float dn = fmaxf(fabsf(s_den[s]), s_em[s]); const float h0 = s_num[s][lane] / dn, h1 = s_num[s][lane + 64] / dn;
                const float ms = wave_sum(h0 * h0 + h1 * h1) * (1.f / 128.f); const float r = 1.f / sqrtf(ms + EPS); const size_t row = row0 + t0 + s;
#pragma unroll
                for (int p = 0; p < 2; ++p) { const int e = lane + 64 * p; const float hh = p ? h1 : h0;
                    const float o = bf2f(U[row * NU + UOM + h * 128 + e]), z = bf2f(U[row * NU + UZM + h * 128 + e]);
                    Y[row * DM + YM + h * 128 + e] = (bf16)f2bf(sigmoidf_(o) * (hh * r * g_head[h * 128 + e]) * siluf_(z)); } }
        }
        __syncthreads();
    }
}

__device__ __forceinline__ void sb_naive_wave(int wu, const bf16* __restrict__ U, const float* __restrict__ g_head, bf16* __restrict__ Y, int lane) {
    const int tb = wu & 31, h = (wu >> 5) & 3, b = wu >> 7, t = tb * 64 + lane;
    const size_t row0 = (size_t)b * SEQ;
    float q[64], acc[64];
    { const v4u* qp = (const v4u*)(U + (row0 + t) * NU + UQS + h * 64);
#pragma unroll
      for (int i = 0; i < 8; ++i) { const v4u w = qp[i]; q[8 * i] = bflo(w.x) * 0.125f; q[8 * i + 1] = bfhi(w.x) * 0.125f; q[8 * i + 2] = bflo(w.y) * 0.125f; q[8 * i + 3] = bfhi(w.y) * 0.125f;
          q[8 * i + 4] = bflo(w.z) * 0.125f; q[8 * i + 5] = bfhi(w.z) * 0.125f; q[8 * i + 6] = bflo(w.w) * 0.125f; q[8 * i + 7] = bfhi(w.w) * 0.125f; } }
#pragma unroll
    for (int d = 0; d < 64; ++d) acc[d] = 0.f;
    float suffix = 0.f;
    for (int s = tb * 64 + 62; s >= 0; --s) {
        const v4u* kp = (const v4u*)(U + (row0 + s) * NU + UKS + h * 64); const v4u* vp = (const v4u*)(U + (row0 + s) * NU + UVS + h * 64);
        float z = 0.f;
#pragma unroll
        for (int i = 0; i < 8; ++i) { const v4u w = kp[i]; z += q[8 * i] * bflo(w.x) + q[8 * i + 1] * bfhi(w.x) + q[8 * i + 2] * bflo(w.y) + q[8 * i + 3] * bfhi(w.y)
                                                         + q[8 * i + 4] * bflo(w.z) + q[8 * i + 5] * bfhi(w.z) + q[8 * i + 6] * bflo(w.w) + q[8 * i + 7] * bfhi(w.w); }
        if (s < t) {
            const float sp = fmaxf(z, 0.f) + log1pf(expf(-fabsf(z)));
            const float a = expf(z - sp - suffix); suffix += sp;
#pragma unroll
            for (int i = 0; i < 8; ++i) { const v4u w = vp[i]; acc[8 * i] += a * bflo(w.x); acc[8 * i + 1] += a * bfhi(w.x); acc[8 * i + 2] += a * bflo(w.y); acc[8 * i + 3] += a * bfhi(w.y);
                acc[8 * i + 4] += a * bflo(w.z); acc[8 * i + 5] += a * bfhi(w.z); acc[8 * i + 6] += a * bflo(w.w); acc[8 * i + 7] += a * bfhi(w.w); }
        }
    }
    float ss = 0.f;
#pragma unroll
    for (int d = 0; d < 64; ++d) ss += acc[d] * acc[d];
    const float r = 1.f / sqrtf(ss * (1.f / 64.f) + EPS);
    const bf16* zp = U + (row0 + t) * NU + UZS + h * 64; bf16* yp = Y + (row0 + t) * DM + YS + h * 64;
#pragma unroll
    for (int d = 0; d < 64; ++d) yp[d] = (bf16)f2bf(acc[d] * r * g_head[h * 64 + d] * siluf_(bf2f(zp[d])));
}

__device__ __forceinline__ void mem_naive_wave(int wu, const bf16* __restrict__ U, const bf16* __restrict__ KVM, const float* __restrict__ g_head, bf16* __restrict__ Y, int lane) {
    const int tb = wu & 31, h = (wu >> 5) & 3, b = wu >> 7, t = tb * 64 + lane;
    const size_t row0 = (size_t)b * SEQ;
    float q[64], acc[64];
    { const v4u* qp = (const v4u*)(U + (row0 + t) * NU + UQC + h * 64);
#pragma unroll
      for (int i = 0; i < 8; ++i) { const v4u w = qp[i]; q[8 * i] = bflo(w.x) * 0.125f; q[8 * i + 1] = bfhi(w.x) * 0.125f; q[8 * i + 2] = bflo(w.y) * 0.125f; q[8 * i + 3] = bfhi(w.y) * 0.125f;
          q[8 * i + 4] = bflo(w.z) * 0.125f; q[8 * i + 5] = bfhi(w.z) * 0.125f; q[8 * i + 6] = bflo(w.w) * 0.125f; q[8 * i + 7] = bfhi(w.w) * 0.125f; } }
#pragma unroll
    for (int d = 0; d < 64; ++d) acc[d] = 0.f;
    float mrun = -1e30f, l = 0.f;
    for (int j = 0; j < NMEM; ++j) {
        const v4u* kp = (const v4u*)(KVM + (size_t)(b * NMEM + j) * 512 + h * 64); const v4u* vp = (const v4u*)(KVM + (size_t)(b * NMEM + j) * 512 + 256 + h * 64);
        float z = 0.f;
#pragma unroll
        for (int i = 0; i < 8; ++i) { const v4u w = kp[i]; z += q[8 * i] * bflo(w.x) + q[8 * i + 1] * bfhi(w.x) + q[8 * i + 2] * bflo(w.y) + q[8 * i + 3] * bfhi(w.y)
                                                         + q[8 * i + 4] * bflo(w.z) + q[8 * i + 5] * bfhi(w.z) + q[8 * i + 6] * bflo(w.w) + q[8 * i + 7] * bfhi(w.w); }
        const float mn = fmaxf(mrun, z), corr = expf(mrun - mn), p = expf(z - mn); mrun = mn; l = l * corr + p;
#pragma unroll
        for (int i = 0; i < 8; ++i) { const v4u w = vp[i]; acc[8 * i] = acc[8 * i] * corr + p * bflo(w.x); acc[8 * i + 1] = acc[8 * i + 1] * corr + p * bfhi(w.x);
            acc[8 * i + 2] = acc[8 * i + 2] * corr + p * bflo(w.y); acc[8 * i + 3] = acc[8 * i + 3] * corr + p * bfhi(w.y);
            acc[8 * i + 4] = acc[8 * i + 4] * corr + p * bflo(w.z); acc[8 * i + 5] = acc[8 * i + 5] * corr + p * bfhi(w.z);
            acc[8 * i + 6] = acc[8 * i + 6] * corr + p * bflo(w.w); acc[8 * i + 7] = acc[8 * i + 7] * corr + p * bfhi(w.w); }
    }
    const float il = 1.f / l; float ss = 0.f;
#pragma unroll
    for (int d = 0; d < 64; ++d) { acc[d] *= il; ss += acc[d] * acc[d]; }
    const float r = 1.f / sqrtf(ss * (1.f / 64.f) + EPS);
    const bf16* zp = U + (row0 + t) * NU + UZC + h * 64; bf16* yp = Y + (row0 + t) * DM + YC + h * 64;
#pragma unroll
    for (int d = 0; d < 64; ++d) yp[d] = (bf16)f2bf(acc[d] * r * g_head[h * 64 + d] * siluf_(bf2f(zp[d])));
}

__device__ __forceinline__ void final_rows(const float* __restrict__ x, const float* __restrict__ g_post, float* out, int gw, int NGW, int lane) {
    for (int m = gw; m < M; m += NGW) {
        const f32x4* zr = (const f32x4*)(out + (size_t)m * DM) + lane; const f32x4* xr = (const f32x4*)(x + (size_t)m * DM) + lane; const f32x4* gr = (const f32x4*)g_post + lane;
        f32x4 v[4]; float s = 0.f;
#pragma unroll
        for (int j = 0; j < 4; ++j) { v[j] = zr[64 * j]; s += (v[j].x * v[j].x + v[j].y * v[j].y) + (v[j].z * v[j].z + v[j].w * v[j].w); }
        const float rstd = 1.f / sqrtf(wave_sum(s) * (1.f / DM) + EPS);
        f32x4* orow = (f32x4*)(out + (size_t)m * DM) + lane;
#pragma unroll
        for (int j = 0; j < 4; ++j) orow[64 * j] = xr[64 * j] + v[j] * rstd * gr[64 * j];
    }
}

constexpr int LDS_BYTES = 147456;
struct Args {
    const float *x, *mem, *g_pre, *w_in, *conv_w, *conv_b, *i_bias, *f_bias, *g_mh, *g_sh, *g_ch, *g_mem, *w_kv, *w_out, *g_post;
    float* out; unsigned char* ws;
};

__global__ void __launch_bounds__(512, 2) hybrid_fwd(Args a) {
    extern __shared__ __attribute__((aligned(16))) unsigned char lds[];
    cg::grid_group grid = cg::this_grid();
    const int tid = threadIdx.x, lane = tid & 63, wave = __builtin_amdgcn_readfirstlane(tid >> 6);
    const int nb = (int)gridDim.x, bx = (int)blockIdx.x;
    unsigned char* ws = a.ws;
    bf16* WIN = (bf16*)(ws + WS_WIN); bf16* WO = (bf16*)(ws + WS_WO); bf16* WKV = (bf16*)(ws + WS_WKV); float* G = (float*)(ws + WS_G);
    bf16* MEMN = (bf16*)(ws + WS_MEMN); bf16* KVM = (bf16*)(ws + WS_KVM); bf16* XN = (bf16*)(ws + WS_XN); bf16* Y = (bf16*)(ws + WS_Y); bf16* U = (bf16*)(ws + WS_U);

    { ProArgs pa{a.x, a.mem, a.g_pre, a.w_in, a.i_bias, a.f_bias, a.g_mem, a.w_kv, a.w_out, WIN, WO, WKV, XN, MEMN, G};
      phase_prologue(pa, (float*)lds, nb, bx); }
    grid.sync();

    { pg8::Gemm g{XN, WIN, M, NU, DM}; pg8::StaticOrder S; S.init(M, NU, nb, bx);
      pg8::EpiBf16<0> E{U, NU, nullptr, 0, 0, 1.f};
      pg8::gemm_phase<pg8::EpiBf16<0>, pg8::StaticOrder, true, true>((PG8_LAS unsigned char*)lds, g, S, E); }
    { pg8::Gemm g{MEMN, WKV, MMEM, 512, DM}; pg8::StaticOrder S; S.init(MMEM, 512, nb, bx);
      pg8::EpiBf16<0> E{KVM, 512, nullptr, 0, 0, 1.f};
      pg8::gemm_phase<pg8::EpiBf16<0>, pg8::StaticOrder, true, true>((PG8_LAS unsigned char*)lds, g, S, E); }
    grid.sync();

    {
        for (int u = bx; u < 128; u += nb) mlstm_naive_unit(u >> 2, u & 3, U, G, a.conv_w, a.conv_b, a.g_mh, Y, (float*)lds);
        for (int wu = bx * 8 + wave; wu < 4096; wu += nb * 8) sb_naive_wave(wu, U, a.g_sh, Y, lane);
        for (int wu = bx * 8 + wave; wu < 4096; wu += nb * 8) mem_naive_wave(wu, U, KVM, a.g_ch, Y, lane);
    }
    grid.sync();

    { pg8::Gemm g{Y, WO, M, DM, DM}; pg8::StaticOrder S; S.init(M, DM, nb, bx);
      pg8::EpiF32 E{a.out, DM};
      pg8::gemm_phase<pg8::EpiF32, pg8::StaticOrder, true, true>((PG8_LAS unsigned char*)lds, g, S, E); }
    grid.sync();

    final_rows(a.x, a.g_post, a.out, bx * 8 + wave, nb * 8, lane);
}

extern "C" void kernel_launch(void* const* d_in, const int* in_sizes, int n_in, void* d_out, int out_size, void* d_ws, size_t ws_size, hipStream_t stream) {
    static int grid_blocks = 0;
    if (grid_blocks == 0) {
        if (n_in != 15 || out_size != M * DM || ws_size < WS_END) { fprintf(stderr, "kernel_launch: unexpected shapes (n_in %d out %d ws %zu)\n", n_in, out_size, ws_size); grid_blocks = -1; return; }
        int dev = 0, cus = 0, per_cu = 0;
        (void)hipGetDevice(&dev); (void)hipDeviceGetAttribute(&cus, hipDeviceAttributeMultiprocessorCount, dev);
        if (hipFuncSetAttribute((const void*)hybrid_fwd, hipFuncAttributeMaxDynamicSharedMemorySize, LDS_BYTES) != hipSuccess) { fprintf(stderr, "kernel_launch: hipFuncSetAttribute failed\n"); grid_blocks = -1; return; }
        if (hipOccupancyMaxActiveBlocksPerMultiprocessor(&per_cu, (const void*)hybrid_fwd, 512, LDS_BYTES) != hipSuccess || per_cu < 1) { fprintf(stderr, "kernel_launch: occupancy query says %d blocks per CU\n", per_cu); per_cu = 1; }
        (void)hipGetLastError();
        if (per_cu > 1) per_cu = 1;
        grid_blocks = cus * per_cu;
    }
    if (grid_blocks < 0) return;
    Args a{};
    a.x = (const float*)d_in[0]; a.mem = (const float*)d_in[1]; a.g_pre = (const float*)d_in[2]; a.w_in = (const float*)d_in[3];
    a.conv_w = (const float*)d_in[4]; a.conv_b = (const float*)d_in[5]; a.i_bias = (const float*)d_in[6]; a.f_bias = (const float*)d_in[7];
    a.g_mh = (const float*)d_in[8]; a.g_sh = (const float*)d_in[9]; a.g_ch = (const float*)d_in[10]; a.g_mem = (const float*)d_in[11];
    a.w_kv = (const float*)d_in[12]; a.w_out = (const float*)d_in[13]; a.g_post = (const float*)d_in[14];
    a.out = (float*)d_out; a.ws = (unsigned char*)d_ws;
    void* args[] = {&a};
    hipError_t e = hipLaunchCooperativeKernel((const void*)hybrid_fwd, dim3(grid_blocks), dim3(512), args, LDS_BYTES, stream);
    if (e != hipSuccess) fprintf(stderr, "kernel_launch: cooperative launch failed: %s (grid %d)\n", hipGetErrorString(e), grid_blocks);
}
```

```cpp
#include <hip/hip_runtime.h>
#include <hip/hip_cooperative_groups.h>
#include <cstdio>
#include <cstdint>
namespace cg = cooperative_groups;
namespace pg8 {
#define PG8_LAS __attribute__((address_space(3)))
typedef unsigned short bf16_t;
typedef short bf16x8 __attribute__((ext_vector_type(8)));
typedef float f32x4 __attribute__((ext_vector_type(4)));
typedef unsigned u32x4 __attribute__((ext_vector_type(4)));
constexpr int BM = 256, BK = 64, HALF = 128, HTB = HALF * BK * 2  , STAGE_BYTES = 8 * HTB, NXCD = 8, WGM = 8;

__host__ __device__ __forceinline__ int lds_byte(int r, int c) { const int st = (r >> 4) * 2 + (c >> 5), rr = r & 15, cc = c & 31, ob = rr * 64 + cc * 2; return st * 1024 + (ob ^ (((ob >> 9) & 1) << 5)); }
__host__ __device__ __forceinline__ void stage_rc(int b, int& R, int& C) { const int st = b / 1024, sb = b % 1024, swz = sb ^ (((sb >> 9) & 1) << 5); R = (st >> 1) * 16 + swz / 64; C = (st & 1) * 32 + (swz % 64) / 2; }
__host__ __device__ __forceinline__ int perm32(int rho) { const int n = rho >> 4, i = rho & 15; return 8 * (i >> 2) + 4 * n + (i & 3); }

struct Unit { int pm, pn; };
struct Gemm { const bf16_t* A; const bf16_t* Bt; int M, N, K; };

struct StaticOrder {
    int nM, nN, nwg, G, c;
    __host__ __device__ void init(int M, int N, int G_, int c_) { nM = M / BM; nN = N / BM; nwg = nM * nN; G = G_; c = c_; }
    __host__ __device__ bool next(int i, Unit& u) const {
        const long L = (long)i * G + c; if (L >= nwg) return false;
        int wgid = (int)L; { const int q = nwg / NXCD, r = nwg % NXCD, xcd = wgid % NXCD, off = wgid / NXCD; wgid = (xcd < r ? xcd * (q + 1) : r * (q + 1) + (xcd - r) * q) + off; }
        const int nig = WGM * nN, gid = wgid / nig, fm = gid * WGM, gsz = (nM - fm) < WGM ? (nM - fm) : WGM;
        u.pm = fm + ((wgid % nig) % gsz); u.pn = (wgid % nig) / gsz; return true;
    }
    __device__ __forceinline__ void a_ready(const Unit&) const {}
    __device__ __forceinline__ void done(const Unit&) const {}
};

__device__ __forceinline__ unsigned cvt_pk_bf16(float lo, float hi) { unsigned r; asm volatile("v_cvt_pk_bf16_f32 %0, %1, %2" : "=v"(r) : "v"(lo), "v"(hi)); return r; }
typedef float f32x2 __attribute__((ext_vector_type(2)));
__device__ __forceinline__ f32x2 gelu_pk(f32x2 v) {
    const f32x2 av = __builtin_elementwise_abs(v), d = av * 0.2316418882f + 1.0f;
    f32x2 t; t.x = __builtin_amdgcn_rcpf(d.x); t.y = __builtin_amdgcn_rcpf(d.y);
    f32x2 q = t * 0.5307027145f + (-0.7265760135f); q = q * t + 0.7107068705f; q = q * t + (-0.142248368f); q = q * t + 0.127414796f; q = q * t;
    const f32x2 s = (v * v) * (-0.72134752044f);
    f32x2 e; e.x = __builtin_amdgcn_exp2f(s.x); e.y = __builtin_amdgcn_exp2f(s.y);
    const f32x2 m = v * (q * e), r = v - m;
    f32x2 o; o.x = v.x < 0.f ? m.x : r.x; o.y = v.y < 0.f ? m.y : r.y; return o;
}

template <int ACT  > struct EpiBf16 {
    static constexpr bool PERM = true, AFTER_DRAIN = false; static_assert(ACT == 0 || ACT == 1, "EpiBf16: ACT is 0 (none) or 1 (gelu_pk)");
    bf16_t* O; int ldc; const float* bias; int split_cols; size_t split_stride; float scale0;
    __device__ __forceinline__ void operator()(const f32x4 (&acc)[2][2][4][2], const Unit& u, int wr, int wc, int fr, int fq) const {
        const int row0 = u.pm * BM + wr * 64 + fr; int colt = u.pn * BM; bf16_t* base = O;
        float sc = 1.f; if (split_cols) { const int t = colt / split_cols; base += (size_t)t * split_stride; colt -= t * split_cols; if (t == 0) sc = scale0; }
        const int col0 = colt + wc * 32 + 8 * fq, bcol0 = u.pn * BM + wc * 32 + 8 * fq;
        f32x4 bv[2][2];
#pragma unroll
        for (int bj = 0; bj < 2; ++bj)
#pragma unroll
            for (int n = 0; n < 2; ++n) bv[bj][n] = bias ? *(const f32x4*)(bias + bcol0 + bj * HALF + 4 * n) : (f32x4){0.f, 0.f, 0.f, 0.f};
#pragma unroll
        for (int ai = 0; ai < 2; ++ai)
#pragma unroll
            for (int m = 0; m < 4; ++m) { bf16_t* rowp = base + (size_t)(row0 + ai * HALF + m * 16) * ldc + col0;
#pragma unroll
                for (int bj = 0; bj < 2; ++bj) { f32x4 v0 = acc[ai][bj][m][0] + bv[bj][0], v1 = acc[ai][bj][m][1] + bv[bj][1];
                    if (ACT == 1) { f32x2 a = gelu_pk((f32x2){v0[0], v0[1]}), b = gelu_pk((f32x2){v0[2], v0[3]}), c = gelu_pk((f32x2){v1[0], v1[1]}), d = gelu_pk((f32x2){v1[2], v1[3]});
                        v0 = (f32x4){a.x, a.y, b.x, b.y}; v1 = (f32x4){c.x, c.y, d.x, d.y}; }
                    v0 = v0 * sc; v1 = v1 * sc; u32x4 w; w.x = cvt_pk_bf16(v0[0], v0[1]); w.y = cvt_pk_bf16(v0[2], v0[3]); w.z = cvt_pk_bf16(v1[0], v1[1]); w.w = cvt_pk_bf16(v1[2], v1[3]);
                    *(u32x4*)(rowp + bj * HALF) = w; } }
    }
};
struct EpiF32 {
    static constexpr bool PERM = false, AFTER_DRAIN = false;
    float* O; int ldc;
    __device__ __forceinline__ void operator()(const f32x4 (&acc)[2][2][4][2], const Unit& u, int wr, int wc, int fr, int fq) const {
        const int col0 = u.pn * BM + wc * 32 + 4 * fq;
#pragma unroll
        for (int ai = 0; ai < 2; ++ai)
#pragma unroll
            for (int m = 0; m < 4; ++m) { const int r = ai * HALF + wr * 64 + m * 16 + fr; float* rowp = O + (size_t)(u.pm * BM + r) * ldc + col0;
#pragma unroll
                for (int bj = 0; bj < 2; ++bj)
#pragma unroll
                    for (int n = 0; n < 2; ++n) *(f32x4*)(rowp + bj * HALF + n * 16) = acc[ai][bj][m][n]; }
    }
};
template <class Epi, class Sched, bool ALIGN_EPI = false, bool SP2 = false>
__device__ __forceinline__ void gemm_phase(PG8_LAS unsigned char* lds, const Gemm g, const Sched& S, const Epi& E) {
    const int tid = threadIdx.x, wid = __builtin_amdgcn_readfirstlane(tid >> 6), lane = tid & 63, wr = wid >> 2, wc = wid & 3, fr = lane & 15, fq = lane >> 4;
    const int K = g.K, nt = K / BK;
    unsigned voffA[2], voffB[2];
#pragma unroll
    for (int i = 0; i < 2; ++i) { int R, C; stage_rc(tid * 16 + i * 8192, R, C); const int Rb = Epi::PERM ? ((R & ~31) + perm32(R & 31)) : R;
        voffA[i] = (unsigned)(R * K + C) * 2u; voffB[i] = (unsigned)(Rb * K + C) * 2u; }
    const size_t kstep = (size_t)(BK * 2);
    const size_t hstep = (size_t)HALF * K * 2;
    const size_t tstep = 2 * hstep;
    const unsigned ldsw = (unsigned)wid * 1024u;
    const int aoff = lds_byte(wr * 64 + fr, fq * 8), boff = lds_byte(wc * 32 + fr, fq * 8);
#define PG8_SA(b, h) (((b) * 2 + (h)) * HTB)
#define PG8_SB(b, h) ((4 + (b) * 2 + (h)) * HTB)
#define PG8_STAGE(bufoff, gbase, voff) do { _Pragma("unroll") for (int _i = 0; _i < 2; ++_i) \
        __builtin_amdgcn_global_load_lds((const unsigned*)((const char*)(gbase) + (voff)[_i]), (PG8_LAS unsigned*)(lds + (bufoff) + ldsw + _i * 8192), 16, 0, 0); } while (0)
#define PG8_LDA(dst, b, h) do { _Pragma("unroll") for (int m = 0; m < 4; ++m) _Pragma("unroll") for (int k = 0; k < 2; ++k) dst[m][k] = *(const PG8_LAS bf16x8*)(lds + PG8_SA(b, h) + aoff + m * 2048 + k * 1024); } while (0)
#define PG8_LDB(dst, b, h) do { _Pragma("unroll") for (int n = 0; n < 2; ++n) _Pragma("unroll") for (int k = 0; k < 2; ++k) dst[n][k] = *(const PG8_LAS bf16x8*)(lds + PG8_SB(b, h) + boff + n * 2048 + k * 1024); } while (0)
#define PG8_MMA(ai, bj, At, Bt) do { __builtin_amdgcn_s_setprio(1); _Pragma("unroll") for (int m = 0; m < 4; ++m) _Pragma("unroll") for (int n = 0; n < 2; ++n) _Pragma("unroll") for (int k = 0; k < 2; ++k) \
        acc[ai][bj][m][n] = __builtin_amdgcn_mfma_f32_16x16x32_bf16(Bt[n][k], At[m][k], acc[ai][bj][m][n], 0, 0, 0); __builtin_amdgcn_s_setprio(0); } while (0)
#define PG8_WAIT_V(n) asm volatile("s_waitcnt vmcnt(" #n ")" ::: "memory")
#define PG8_WAIT_L(n) asm volatile("s_waitcnt lgkmcnt(" #n ")" ::: "memory")
#define PG8_BAR __builtin_amdgcn_s_barrier()
#define PG8_SCHED __builtin_amdgcn_sched_barrier(0)
    Unit cur, nxt; int ui = 0;
    if (!S.next(0, cur)) return;
    f32x4 acc[2][2][4][2];
#pragma unroll
    for (int a = 0; a < 2; ++a)
#pragma unroll
        for (int b = 0; b < 2; ++b)
#pragma unroll
            for (int m = 0; m < 4; ++m)
#pragma unroll
                for (int n = 0; n < 2; ++n) acc[a][b][m][n] = (f32x4){0.f, 0.f, 0.f, 0.f};
    bf16x8 At[4][2], B0[2][2], B1[2][2];
    const char* cA = (const char*)g.A + (size_t)cur.pm * tstep; const char* cB = (const char*)g.Bt + (size_t)cur.pn * tstep;
    S.a_ready(cur);
    if constexpr (SP2) {
        PG8_STAGE(PG8_SB(0, 0), cB, voffB); PG8_STAGE(PG8_SB(0, 1), cB + hstep, voffB); PG8_STAGE(PG8_SA(0, 0), cA, voffA); PG8_STAGE(PG8_SA(0, 1), cA + hstep, voffA);
        if (wr == 1) PG8_BAR;
        PG8_WAIT_V(2); PG8_BAR;
        PG8_STAGE(PG8_SB(1, 0), cB + kstep, voffB); PG8_STAGE(PG8_SA(1, 0), cA + kstep, voffA); PG8_STAGE(PG8_SB(1, 1), cB + hstep + kstep, voffB);
        PG8_WAIT_V(6); PG8_BAR;
    } else {
        PG8_STAGE(PG8_SB(0, 0), cB, voffB); PG8_STAGE(PG8_SA(0, 0), cA, voffA); PG8_STAGE(PG8_SB(0, 1), cB + hstep, voffB); PG8_STAGE(PG8_SA(0, 1), cA + hstep, voffA);
        if (wr == 1) PG8_BAR;
        PG8_WAIT_V(4); PG8_BAR;
        PG8_STAGE(PG8_SB(1, 0), cB + kstep, voffB); PG8_STAGE(PG8_SA(1, 0), cA + kstep, voffA); PG8_STAGE(PG8_SB(1, 1), cB + hstep + kstep, voffB);
        PG8_WAIT_V(6); PG8_BAR;
    }
    for (;;) {
        const bool has_next = S.next(ui + 1, nxt);
        const char* nA = has_next ? (const char*)g.A + (size_t)nxt.pm * tstep : cA; const char* nB = has_next ? (const char*)g.Bt + (size_t)nxt.pn * tstep : cB;
        for (int t = 0; t < nt; t += 2) {
            const bool last = (t == nt - 2);
            const char* a1 = cA + (size_t)(t + 1) * kstep;
            const char* a2 = last ? nA : cA + (size_t)(t + 2) * kstep; const char* b2 = last ? nB : cB + (size_t)(t + 2) * kstep;
            const char* a3 = a2 + kstep; const char* b3 = b2 + kstep;
            if (last && has_next) S.a_ready(nxt);
            if constexpr (SP2) {
            PG8_LDB(B0, 0, 0); PG8_LDB(B1, 0, 1); PG8_SCHED; PG8_LDA(At, 0, 0); PG8_STAGE(PG8_SA(1, 1), a1 + hstep, voffA);
            PG8_WAIT_V(8); PG8_WAIT_L(0); PG8_BAR; PG8_MMA(0, 0, At, B0); PG8_MMA(0, 1, At, B1); PG8_BAR; PG8_SCHED;
            PG8_LDA(At, 0, 1); PG8_STAGE(PG8_SB(0, 0), b2, voffB); PG8_STAGE(PG8_SB(0, 1), b2 + hstep, voffB); PG8_STAGE(PG8_SA(0, 0), a2, voffA);
            PG8_WAIT_V(8); PG8_WAIT_L(0); PG8_BAR; PG8_MMA(1, 0, At, B0); PG8_MMA(1, 1, At, B1); PG8_BAR; PG8_SCHED;
            PG8_LDB(B0, 1, 0); PG8_LDB(B1, 1, 1); PG8_SCHED; PG8_LDA(At, 1, 0); PG8_STAGE(PG8_SA(0, 1), a2 + hstep, voffA);
            PG8_WAIT_V(8); PG8_WAIT_L(0); PG8_BAR; PG8_MMA(0, 0, At, B0); PG8_MMA(0, 1, At, B1); PG8_BAR; PG8_SCHED;
            PG8_LDA(At, 1, 1); PG8_STAGE(PG8_SB(1, 0), b3, voffB); PG8_STAGE(PG8_SB(1, 1), b3 + hstep, voffB); PG8_STAGE(PG8_SA(1, 0), a3, voffA);
            PG8_WAIT_V(8); PG8_WAIT_L(0); PG8_BAR; PG8_MMA(1, 0, At, B0); PG8_MMA(1, 1, At, B1); PG8_BAR; PG8_SCHED;
            } else {
            PG8_LDB(B0, 0, 0); PG8_SCHED; PG8_LDA(At, 0, 0); PG8_STAGE(PG8_SA(1, 1), a1 + hstep, voffA);
            PG8_WAIT_L(8); PG8_BAR; PG8_WAIT_L(0); PG8_MMA(0, 0, At, B0); PG8_BAR; PG8_SCHED;
            PG8_LDB(B1, 0, 1); PG8_STAGE(PG8_SB(0, 0), b2, voffB);
            PG8_BAR; PG8_WAIT_L(0); PG8_MMA(0, 1, At, B1); PG8_BAR;
            PG8_LDA(At, 0, 1); PG8_STAGE(PG8_SA(0, 0), a2, voffA);
            PG8_BAR; PG8_WAIT_L(0); PG8_MMA(1, 0, At, B0); PG8_BAR; PG8_SCHED;
            PG8_STAGE(PG8_SB(0, 1), b2 + hstep, voffB);
            PG8_WAIT_V(6); PG8_BAR; PG8_MMA(1, 1, At, B1); PG8_BAR;
            PG8_LDB(B0, 1, 0); PG8_SCHED; PG8_LDA(At, 1, 0); PG8_STAGE(PG8_SA(0, 1), a2 + hstep, voffA);
            PG8_WAIT_L(8); PG8_BAR; PG8_WAIT_L(0); PG8_MMA(0, 0, At, B0); PG8_BAR; PG8_SCHED;
            PG8_LDB(B1, 1, 1); PG8_STAGE(PG8_SB(1, 0), b3, voffB);
            PG8_BAR; PG8_WAIT_L(0); PG8_MMA(0, 1, At, B1); PG8_BAR;
            PG8_LDA(At, 1, 1); PG8_STAGE(PG8_SA(1, 0), a3, voffA);
            PG8_BAR; PG8_WAIT_L(0); PG8_MMA(1, 0, At, B0); PG8_BAR; PG8_SCHED;
            PG8_STAGE(PG8_SB(1, 1), b3 + hstep, voffB);
            PG8_WAIT_V(6); PG8_BAR; PG8_MMA(1, 1, At, B1); PG8_BAR;
            }
        }
        if constexpr (ALIGN_EPI) { if (wr == 0) PG8_BAR; }
        if constexpr (!Epi::AFTER_DRAIN) { E(acc, cur, wr, wc, fr, fq); S.done(cur); }
        if (!has_next) break;
#pragma unroll
        for (int a = 0; a < 2; ++a)
#pragma unroll
            for (int b = 0; b < 2; ++b)
#pragma unroll
                for (int m = 0; m < 4; ++m)
#pragma unroll
                    for (int n = 0; n < 2; ++n) acc[a][b][m][n] = (f32x4){0.f, 0.f, 0.f, 0.f};
        cur = nxt; cA = nA; cB = nB; ++ui;
        if constexpr (ALIGN_EPI) { if (wr == 1) PG8_BAR; }
    }
    PG8_WAIT_V(0);
    if constexpr (!ALIGN_EPI) { if (wr == 0) PG8_BAR; }
    PG8_BAR;
    if constexpr (Epi::AFTER_DRAIN) { E.fused(acc, cur, wr, wc, fr, fq, lds, wid, lane); S.done(cur); }
#undef PG8_SA
#undef PG8_SB
#undef PG8_STAGE
#undef PG8_LDA
#undef PG8_LDB
#undef PG8_MMA
#undef PG8_WAIT_V
#undef PG8_WAIT_L
#undef PG8_BAR
#undef PG8_SCHED
}
}

constexpr int BATCH = 32, SEQ = 2048, DM = 1024, M = BATCH * SEQ;
constexpr int DIN = 4104, NU = 4096;
constexpr int NMEM = 256, MMEM = BATCH * NMEM;
constexpr int UQM = 0, UKM = 512, UVM = 1024, UOM = 1536, UZM = 2048, UQS = 2560, UKS = 2816, UVS = 3072, UZS = 3328, UQC = 3584, UZC = 3840;
constexpr int WIF = 2560;
constexpr float EPS = 1e-6f;
constexpr int YM = 0, YS = 512, YC = 768;

constexpr size_t MiB = 1u << 20;
constexpr size_t WS_CTL = 0, CTL_ZERO_BYTES = 1 * MiB;
constexpr size_t WS_WIN = 2 * MiB;
constexpr size_t WS_WO = 10 * MiB;
constexpr size_t WS_WKV = 12 * MiB;
constexpr size_t WS_G = 14 * MiB;
constexpr size_t WS_MEMN = 16 * MiB;
constexpr size_t WS_KVM = 32 * MiB;
constexpr size_t WS_XN = 64 * MiB;
constexpr size_t WS_Y = 64 * MiB;
constexpr size_t WS_U = 192 * MiB;
constexpr size_t WS_END = 704 * MiB;

typedef unsigned short bf16;
typedef float f32x4 __attribute__((ext_vector_type(4)));
typedef unsigned v4u __attribute__((ext_vector_type(4)));
typedef unsigned v2u __attribute__((ext_vector_type(2)));
#define LAS __attribute__((address_space(3)))

__device__ __forceinline__ unsigned f2bf(float f) { unsigned u = __builtin_bit_cast(unsigned, f); return (u + 0x7fffu + ((u >> 16) & 1u)) >> 16; }
__device__ __forceinline__ unsigned pk2(float lo, float hi) { return f2bf(lo) | (f2bf(hi) << 16); }
__device__ __forceinline__ float bf2f(unsigned h) { return __builtin_bit_cast(float, h << 16); }
__device__ __forceinline__ float bflo(unsigned w) { return __builtin_bit_cast(float, w << 16); }
__device__ __forceinline__ float bfhi(unsigned w) { return __builtin_bit_cast(float, w & 0xffff0000u); }
__device__ __forceinline__ float wave_sum(float v) {
#pragma unroll
    for (int o = 1; o < 64; o <<= 1) v += __shfl_xor(v, o);
    return v;
}
__device__ __forceinline__ float sigmoidf_(float x) { return 1.f / (1.f + __expf(-x)); }
__device__ __forceinline__ float siluf_(float x) { return x / (1.f + __expf(-x)); }

__device__ __forceinline__ void transpose_item(const float* W, int Nsrc, int K, bf16* WT, const float* gk, float* scr, int kb, int n0_dst, int n0_src, int lane) {
    const int k0 = 64 * kb;
#pragma unroll 8
    for (int i = 0; i < 32; ++i) { const int kk = 2 * i + (lane >> 5); const float g = gk ? gk[k0 + kk] : 1.f; scr[kk * 33 + (lane & 31)] = g * W[(size_t)(k0 + kk) * Nsrc + n0_src + (lane & 31)]; }
    __builtin_amdgcn_s_waitcnt(0xC07F); asm volatile("" ::: "memory");
    const int c = lane & 7;
#pragma unroll
    for (int j = 0; j < 4; ++j) { const int n = (lane >> 3) + 8 * j; const float* s = scr + (8 * c) * 33 + n;
        v4u o; o.x = pk2(s[0 * 33], s[1 * 33]); o.y = pk2(s[2 * 33], s[3 * 33]); o.z = pk2(s[4 * 33], s[5 * 33]); o.w = pk2(s[6 * 33], s[7 * 33]);
        *(v4u*)(WT + (size_t)(n0_dst + n) * K + k0 + 8 * c) = o; }
    __builtin_amdgcn_s_waitcnt(0xC07F); asm volatile("" ::: "memory");
}

struct ProArgs {
    const float *x, *mem, *g_pre, *w_in, *i_bias, *f_bias, *g_mem, *w_mem_kv, *w_out;
    bf16 *WIN, *WO, *WKV, *XN, *MEMN; float* G;
};

template <bool GATES>
__device__ __forceinline__ void row_item(const float* xrow, bf16* orow, float* grow, const float* wif, const float* i_bias, const float* f_bias, int h_unused, int lane) {
    const f32x4* xr = (const f32x4*)xrow + lane;
    f32x4 v[4]; float s = 0.f;
#pragma unroll
    for (int j = 0; j < 4; ++j) { v[j] = xr[64 * j]; s += (v[j].x * v[j].x + v[j].y * v[j].y) + (v[j].z * v[j].z + v[j].w * v[j].w); }
    const float rstd = 1.f / sqrtf(wave_sum(s) * (1.f / DM) + EPS);
#pragma unroll
    for (int j = 0; j < 4; ++j) v[j] = v[j] * rstd;
    unsigned long long* o8 = (unsigned long long*)orow + lane;
#pragma unroll
    for (int j = 0; j < 4; ++j) o8[64 * j] = (unsigned long long)pk2(v[j].x, v[j].y) | ((unsigned long long)pk2(v[j].z, v[j].w) << 32);
    if (GATES) {
        float a[8];
#pragma unroll
        for (int g = 0; g < 8; ++g) a[g] = 0.f;
#pragma unroll
        for (int j = 0; j < 4; ++j)
#pragma unroll
            for (int c = 0; c < 4; ++c) { const int k = 4 * (lane + 64 * j) + c; const float xv = v[j][c]; const f32x4 w0 = *(const f32x4*)(wif + k * 8), w1 = *(const f32x4*)(wif + k * 8 + 4);
                a[0] += xv * w0.x; a[1] += xv * w0.y; a[2] += xv * w0.z; a[3] += xv * w0.w; a[4] += xv * w1.x; a[5] += xv * w1.y; a[6] += xv * w1.z; a[7] += xv * w1.w; }
#pragma unroll
        for (int g = 0; g < 8; ++g) a[g] = wave_sum(a[g]);
        float val = a[0];
#pragma unroll
        for (int g = 1; g < 8; ++g) if (lane == g) val = a[g];
        if (lane < 4) grow[lane] = val + i_bias[lane];
        else if (lane < 8) { const float xx = val + f_bias[lane - 4]; grow[lane] = fminf(xx, 0.f) - log1pf(expf(-fabsf(xx))); }
    }
}

__device__ __forceinline__ void phase_prologue(const ProArgs& a, float* sh, int nblocks, int block) {
    const int tid = threadIdx.x, lane = tid & 63, wave = tid >> 6;
    float* scr = sh + wave * 2112; float* wif = sh + 8 * 2112;
    for (int i = tid; i < 8192; i += 512) { const int k = i >> 3, g = i & 7; wif[i] = a.g_pre[k] * a.w_in[(size_t)k * DIN + WIF + g]; }
    __syncthreads();
    const int gw = block * 8 + wave, NGW = nblocks * 8;
    constexpr int I_IN = 16 * 128, I_O = 16 * 32, I_KV = 16 * 16, NIT = I_IN + I_O + I_KV;
    for (int it = gw; it < NIT; it += NGW) {
        int r = it;
        if (r < I_IN) { const int kb = r / 128, nb = r % 128, n0 = 32 * nb; transpose_item(a.w_in, DIN, DM, a.WIN, a.g_pre, scr, kb, n0, n0 + (n0 >= WIF ? 8 : 0), lane); continue; } r -= I_IN;
        if (r < I_O) { const int kb = r / 32, nb = r % 32; transpose_item(a.w_out, DM, DM, a.WO, nullptr, scr, kb, 32 * nb, 32 * nb, lane); continue; } r -= I_O;
        { const int kb = r / 16, nb = r % 16; transpose_item(a.w_mem_kv, 512, DM, a.WKV, a.g_mem, scr, kb, 32 * nb, 32 * nb, lane); }
    }
    for (int m = gw; m < M; m += NGW) row_item<true>(a.x + (size_t)m * DM, a.XN + (size_t)m * DM, a.G + (size_t)m * 8, wif, a.i_bias, a.f_bias, 0, lane);
    for (int m = gw; m < MMEM; m += NGW) row_item<false>(a.mem + (size_t)m * DM, a.MEMN + (size_t)m * DM, nullptr, wif, nullptr, nullptr, 0, lane);
}

__device__ __forceinline__ void mlstm_naive_unit(int b, int h, const bf16* __restrict__ U, const float* __restrict__ G, const float* __restrict__ conv_w, const float* __restrict__ conv_b,
                                                 const float* __restrict__ g_head, bf16* __restrict__ Y, float* shf) {
    float (*qs)[128] = (float (*)[128])shf; float (*ks)[128] = (float (*)[128])(shf + 2048); float (*vs)[128] = (float (*)[128])(shf + 4096); float (*s_num)[16][128] = (float (*)[16][128])(shf + 6144);
    float (*s_den)[16] = (float (*)[16])(shf + 10240); float* s_fg = shf + 10272; float* s_ig = shf + 10288; float* s_em = shf + 10304;
    const int tid = threadIdx.x, lane = tid & 63, wave = tid >> 6;
    const size_t row0 = (size_t)b * SEQ;
    float C[64];
#pragma unroll
    for (int d = 0; d < 64; ++d) C[d] = 0.f;
    float m = 0.f;
    float wq[4], wk[4], bq = 0.f, bk = 0.f;
    const int ce = tid & 127, dh = (tid >> 7) & 1;
#pragma unroll
    for (int j = 0; j < 4; ++j) { wq[j] = conv_w[j * 1024 + h * 128 + ce]; wk[j] = conv_w[j * 1024 + 512 + h * 128 + ce]; }
    bq = conv_b[h * 128 + ce]; bk = conv_b[512 + h * 128 + ce];
    for (int t0 = 0; t0 < SEQ; t0 += 16) {
        if (tid < 128) {
#pragma unroll 1
            for (int s = 0; s < 16; ++s) {
                float aq = bq, ak = bk;
#pragma unroll
                for (int j = 0; j < 4; ++j) { const int t = t0 + s - 3 + j;
                    if (t >= 0) { aq += wq[j] * bf2f(U[(row0 + t) * NU + UQM + h * 128 + tid]); ak += wk[j] * bf2f(U[(row0 + t) * NU + UKM + h * 128 + tid]); } }
                qs[s][tid] = siluf_(aq); ks[s][tid] = siluf_(ak) * 0.08838834764831845f;
                vs[s][tid] = bf2f(U[(row0 + t0 + s) * NU + UVM + h * 128 + tid]);
            }
        } else if (tid == 258) {
#pragma unroll 1
            for (int s = 0; s < 16; ++s) { const float ip = G[(row0 + t0 + s) * 8 + h], lf = G[(row0 + t0 + s) * 8 + 4 + h]; const float mn = fmaxf(lf + m, ip);
                s_fg[s] = expf(lf + m - mn); s_ig[s] = expf(ip - mn); s_em[s] = expf(-mn); m = mn; }
        }
        __syncthreads();
        if (tid < 258) {
#pragma unroll 1
            for (int s = 0; s < 16; ++s) { const float f = s_fg[s], av = s_ig[s] * (tid < 256 ? vs[s][ce] : 1.f); float num = 0.f;
#pragma unroll
                for (int d = 0; d < 64; d += 4) { const f32x4 k4 = *(const f32x4*)&ks[s][64 * dh + d], q4 = *(const f32x4*)&qs[s][64 * dh + d];
                    C[d] = f * C[d] + av * k4.x; C[d + 1] = f * C[d + 1] + av * k4.y; C[d + 2] = f * C[d + 2] + av * k4.z; C[d + 3] = f * C[d + 3] + av * k4.w;
                    num += C[d] * q4.x + C[d + 1] * q4.y + C[d + 2] * q4.z + C[d + 3] * q4.w; }
                if (tid < 256) s_num[dh][s][ce] = num; else s_den[tid - 256][s] = num; }
        }
        __syncthreads();
        if (wave < 2) {
#pragma unroll 1
            for (int s = wave; s < 16; s += 2) { const float dn = fmaxf(fabsf(s_den[0][s] + s_den[1][s]), s_em[s]);
                const float h0 = (s_num[0][s][lane] + s_num[1][s][lane]) / dn, h1 = (s_num[0][s][lane + 64] + s_num[1][s][lane + 64]) / dn;
                const float ms = wave_sum(h0 * h0 + h1 * h1) * (1.f / 128.f); const float r = 1.f / sqrtf(ms + EPS); const size_t row = row0 + t0 + s;
#pragma unroll
                for (int p = 0; p < 2; ++p) { const int e = lane + 64 * p; const float hh = p ? h1 : h0;
                    const float o = bf2f(U[row * NU + UOM + h * 128 + e]), z = bf2f(U[row * NU + UZM + h * 128 + e]);
                    Y[row * DM + YM + h * 128 + e] = (bf16)f2bf(sigmoidf_(o) * (hh * r * g_head[h * 128 + e]) * siluf_(z)); } }
        }
        __syncthreads();
    }
}

__device__ __forceinline__ void sb_naive_wave(int wu, const bf16* __restrict__ U, const float* __restrict__ g_head, bf16* __restrict__ Y, int lane) {
    const int tb = wu & 31, h = (wu >> 5) & 3, b = wu >> 7, t = tb * 64 + lane;
    const size_t row0 = (size_t)b * SEQ;
    float q[64], acc[64];
    { const v4u* qp = (const v4u*)(U + (row0 + t) * NU + UQS + h * 64);
#pragma unroll
      for (int i = 0; i < 8; ++i) { const v4u w = qp[i]; q[8 * i] = bflo(w.x) * 0.125f; q[8 * i + 1] = bfhi(w.x) * 0.125f; q[8 * i + 2] = bflo(w.y) * 0.125f; q[8 * i + 3] = bfhi(w.y) * 0.125f;
          q[8 * i + 4] = bflo(w.z) * 0.125f; q[8 * i + 5] = bfhi(w.z) * 0.125f; q[8 * i + 6] = bflo(w.w) * 0.125f; q[8 * i + 7] = bfhi(w.w) * 0.125f; } }
#pragma unroll
    for (int d = 0; d < 64; ++d) acc[d] = 0.f;
    float suffix = 0.f;
    for (int s = tb * 64 + 62; s >= 0; --s) {
        const v4u* kp = (const v4u*)(U + (row0 + s) * NU + UKS + h * 64); const v4u* vp = (const v4u*)(U + (row0 + s) * NU + UVS + h * 64);
        float z = 0.f;
#pragma unroll
        for (int i = 0; i < 8; ++i) { const v4u w = kp[i]; z += q[8 * i] * bflo(w.x) + q[8 * i + 1] * bfhi(w.x) + q[8 * i + 2] * bflo(w.y) + q[8 * i + 3] * bfhi(w.y)
                                                         + q[8 * i + 4] * bflo(w.z) + q[8 * i + 5] * bfhi(w.z) + q[8 * i + 6] * bflo(w.w) + q[8 * i + 7] * bfhi(w.w); }
        if (s < t) {
            const float sp = fmaxf(z, 0.f) + log1pf(expf(-fabsf(z)));
            const float a = expf(z - sp - suffix); suffix += sp;
#pragma unroll
            for (int i = 0; i < 8; ++i) { const v4u w = vp[i]; acc[8 * i] += a * bflo(w.x); acc[8 * i + 1] += a * bfhi(w.x); acc[8 * i + 2] += a * bflo(w.y); acc[8 * i + 3] += a * bfhi(w.y);
                acc[8 * i + 4] += a * bflo(w.z); acc[8 * i + 5] += a * bfhi(w.z); acc[8 * i + 6] += a * bflo(w.w); acc[8 * i + 7] += a * bfhi(w.w); }
        }
    }
    float ss = 0.f;
#pragma unroll
    for (int d = 0; d < 64; ++d) ss += acc[d] * acc[d];
    const float r = 1.f / sqrtf(ss * (1.f / 64.f) + EPS);
    const bf16* zp = U + (row0 + t) * NU + UZS + h * 64; bf16* yp = Y + (row0 + t) * DM + YS + h * 64;
#pragma unroll
    for (int d = 0; d < 64; ++d) yp[d] = (bf16)f2bf(acc[d] * r * g_head[h * 64 + d] * siluf_(bf2f(zp[d])));
}

__device__ __forceinline__ void mem_naive_wave(int wu, const bf16* __restrict__ U, const bf16* __restrict__ KVM, const float* __restrict__ g_head, bf16* __restrict__ Y, int lane) {
    const int tb = wu & 31, h = (wu >> 5) & 3, b = wu >> 7, t = tb * 64 + lane;
    const size_t row0 = (size_t)b * SEQ;
    float q[64], acc[64];
    { const v4u* qp = (const v4u*)(U + (row0 + t) * NU + UQC + h * 64);
#pragma unroll
      for (int i = 0; i < 8; ++i) { const v4u w = qp[i]; q[8 * i] = bflo(w.x) * 0.125f; q[8 * i + 1] = bfhi(w.x) * 0.125f; q[8 * i + 2] = bflo(w.y) * 0.125f; q[8 * i + 3] = bfhi(w.y) * 0.125f;
          q[8 * i + 4] = bflo(w.z) * 0.125f; q[8 * i + 5] = bfhi(w.z) * 0.125f; q[8 * i + 6] = bflo(w.w) * 0.125f; q[8 * i + 7] = bfhi(w.w) * 0.125f; } }
#pragma unroll
    for (int d = 0; d < 64; ++d) acc[d] = 0.f;
    float mrun = -1e30f, l = 0.f;
    for (int j = 0; j < NMEM; ++j) {
        const v4u* kp = (const v4u*)(KVM + (size_t)(b * NMEM + j) * 512 + h * 64); const v4u* vp = (const v4u*)(KVM + (size_t)(b * NMEM + j) * 512 + 256 + h * 64);
        float z = 0.f;
#pragma unroll
        for (int i = 0; i < 8; ++i) { const v4u w = kp[i]; z += q[8 * i] * bflo(w.x) + q[8 * i + 1] * bfhi(w.x) + q[8 * i + 2] * bflo(w.y) + q[8 * i + 3] * bfhi(w.y)
                                                         + q[8 * i + 4] * bflo(w.z) + q[8 * i + 5] * bfhi(w.z) + q[8 * i + 6] * bflo(w.w) + q[8 * i + 7] * bfhi(w.w); }
        const float mn = fmaxf(mrun, z), corr = expf(mrun - mn), p = expf(z - mn); mrun = mn; l = l * corr + p;
#pragma unroll
        for (int i = 0; i < 8; ++i) { const v4u w = vp[i]; acc[8 * i] = acc[8 * i] * corr + p * bflo(w.x); acc[8 * i + 1] = acc[8 * i + 1] * corr + p * bfhi(w.x);
            acc[8 * i + 2] = acc[8 * i + 2] * corr + p * bflo(w.y); acc[8 * i + 3] = acc[8 * i + 3] * corr + p * bfhi(w.y);
            acc[8 * i + 4] = acc[8 * i + 4] * corr + p * bflo(w.z); acc[8 * i + 5] = acc[8 * i + 5] * corr + p * bfhi(w.z);
            acc[8 * i + 6] = acc[8 * i + 6] * corr + p * bflo(w.w); acc[8 * i + 7] = acc[8 * i + 7] * corr + p * bfhi(w.w); }
    }
    const float il = 1.f / l; float ss = 0.f;
#pragma unroll
    for (int d = 0; d < 64; ++d) { acc[d] *= il; ss += acc[d] * acc[d]; }
    const float r = 1.f / sqrtf(ss * (1.f / 64.f) + EPS);
    const bf16* zp = U + (row0 + t) * NU + UZC + h * 64; bf16* yp = Y + (row0 + t) * DM + YC + h * 64;
#pragma unroll
    for (int d = 0; d < 64; ++d) yp[d] = (bf16)f2bf(acc[d] * r * g_head[h * 64 + d] * siluf_(bf2f(zp[d])));
}

__device__ __forceinline__ void final_rows(const float* __restrict__ x, const float* __restrict__ g_post, float* out, int gw, int NGW, int lane) {
    for (int m = gw; m < M; m += NGW) {
        const f32x4* zr = (const f32x4*)(out + (size_t)m * DM) + lane; const f32x4* xr = (const f32x4*)(x + (size_t)m * DM) + lane; const f32x4* gr = (const f32x4*)g_post + lane;
        f32x4 v[4]; float s = 0.f;
#pragma unroll
        for (int j = 0; j < 4; ++j) { v[j] = zr[64 * j]; s += (v[j].x * v[j].x + v[j].y * v[j].y) + (v[j].z * v[j].z + v[j].w * v[j].w); }
        const float rstd = 1.f / sqrtf(wave_sum(s) * (1.f / DM) + EPS);
        f32x4* orow = (f32x4*)(out + (size_t)m * DM) + lane;
#pragma unroll
        for (int j = 0; j < 4; ++j) orow[64 * j] = xr[64 * j] + v[j] * rstd * gr[64 * j];
    }
}

namespace mx {
typedef short bf16x8 __attribute__((ext_vector_type(8)));
typedef short s16x4 __attribute__((ext_vector_type(4)));
typedef float f32x16 __attribute__((ext_vector_type(16)));
typedef unsigned u32x4 __attribute__((ext_vector_type(4)));
typedef LAS unsigned char* ldsp;
#define MFMA32(a, b, c) __builtin_amdgcn_mfma_f32_32x32x16_bf16((a), (b), (c), 0, 0, 0)
__device__ __forceinline__ int crow(int r, int hi) { return (r & 3) + 8 * (r >> 2) + 4 * hi; }
__device__ __forceinline__ s16x4 vtr(ldsp p) { return __builtin_bit_cast(s16x4, __builtin_amdgcn_ds_read_tr16_b64_v4i16((LAS s16x4*)p)); }
__device__ __forceinline__ bf16x8 cat8(s16x4 lo, s16x4 hi) { return __builtin_shufflevector(lo, hi, 0, 1, 2, 3, 4, 5, 6, 7); }
__device__ __forceinline__ unsigned cvtpk(float lo, float hi) { typedef float f2 __attribute__((ext_vector_type(2))); typedef __bf16 b2 __attribute__((ext_vector_type(2))); f2 v = {lo, hi}; b2 b = __builtin_convertvector(v, b2); return __builtin_bit_cast(unsigned, b); }
__device__ __forceinline__ bf16x8 pack8(const f32x16& p, int s) {
    u32x4 w; w.x = cvtpk(p[8 * s], p[8 * s + 1]); w.y = cvtpk(p[8 * s + 2], p[8 * s + 3]); w.z = cvtpk(p[8 * s + 4], p[8 * s + 5]); w.w = cvtpk(p[8 * s + 6], p[8 * s + 7]); return __builtin_bit_cast(bf16x8, w); }
constexpr float LOG2E = 1.4426950408889634f;

__device__ __forceinline__ void stage_kv(const bf16* kbase, const bf16* vbase, size_t pitch, ldsp kslot, ldsp vslot, int wid, int lane) {
    const u32x4 kx = *(const u32x4*)(kbase + (size_t)lane * pitch + wid * 8);
    const u32x4 vx = *(const u32x4*)(vbase + (size_t)(16 * (wid & 3) + (lane >> 2)) * pitch + (wid >> 2) * 32 + (lane & 3) * 8);
    *(LAS u32x4*)(kslot + wid * 1024 + lane * 16) = kx;
    *(LAS u32x4*)(vslot + wid * 1024 + lane * 16) = vx;
}
__device__ __forceinline__ void qkt(f32x16& p0, f32x16& p1, ldsp kslot, const bf16x8 (&qr)[4], int r32, int hi) {
    const ldsp kb = kslot + hi * 1024 + r32 * 16;
    f32x16 z;
#pragma unroll
    for (int i = 0; i < 16; ++i) z[i] = 0.f;
    p0 = z; p1 = z;
#pragma unroll
    for (int d0 = 0; d0 < 4; ++d0) { const bf16x8 b0 = *(const LAS bf16x8*)(kb + d0 * 2048), b1 = *(const LAS bf16x8*)(kb + d0 * 2048 + 512);
        p0 = MFMA32(b0, qr[d0], p0); p1 = MFMA32(b1, qr[d0], p1); }
}
__device__ __forceinline__ void qkt_half(f32x16& p, ldsp kslot, const bf16x8 (&qr)[4], int half, int r32, int hi) {
    const ldsp kb = kslot + hi * 1024 + r32 * 16 + half * 512;
#pragma unroll
    for (int i = 0; i < 16; ++i) p[i] = 0.f;
#pragma unroll
    for (int d0 = 0; d0 < 4; ++d0) { const bf16x8 b0 = *(const LAS bf16x8*)(kb + d0 * 2048); p = MFMA32(b0, qr[d0], p); }
}
__device__ __forceinline__ void pv64(f32x16 (&o)[2], ldsp vslot, const bf16x8 (&pa)[4], int lane, int hi) {
    const ldsp vb = vslot + ((lane >> 4) & 1) * 32 + (lane & 3) * 8 + (4 * hi + ((lane & 15) >> 2)) * 64;
#pragma unroll
    for (int d0 = 0; d0 < 2; ++d0)
#pragma unroll
        for (int ks = 0; ks < 4; ++ks) { const s16x4 lo = vtr(vb + d0 * 4096 + ks * 1024), h4 = vtr(vb + d0 * 4096 + ks * 1024 + 512); o[d0] = MFMA32(pa[ks], cat8(lo, h4), o[d0]); }
}
template <bool MASK> __device__ __forceinline__ float sb_half(f32x16& y, float base, int s0, int t, int hi) {
    float sp[16];
#pragma unroll
    for (int r = 0; r < 16; ++r) { const float v = y[r]; float s = fmaxf(v, 0.f) + __builtin_amdgcn_logf(1.f + __builtin_amdgcn_exp2f(-fabsf(v)));
        if (MASK) { if (!(s0 + crow(r, hi) < t)) s = 0.f; } sp[r] = s; }
    float bs[4], ot[4];
#pragma unroll
    for (int g = 0; g < 4; ++g) { bs[g] = (sp[4 * g] + sp[4 * g + 1]) + (sp[4 * g + 2] + sp[4 * g + 3]); ot[g] = __shfl_xor(bs[g], 32); }
    float so[4]; so[3] = 0.f; so[2] = bs[3] + ot[3]; so[1] = so[2] + (bs[2] + ot[2]); so[0] = so[1] + (bs[1] + ot[1]);
    const float total = so[0] + (bs[0] + ot[0]);
#pragma unroll
    for (int g = 0; g < 4; ++g) { const float e = base + so[g] + (hi == 0 ? ot[g] : 0.f);
        const float c3 = e + sp[4 * g + 3], c2 = c3 + sp[4 * g + 2], c1 = c2 + sp[4 * g + 1], c0 = c1 + sp[4 * g];
        float a0 = __builtin_amdgcn_exp2f(y[4 * g] - c0), a1 = __builtin_amdgcn_exp2f(y[4 * g + 1] - c1), a2 = __builtin_amdgcn_exp2f(y[4 * g + 2] - c2), a3 = __builtin_amdgcn_exp2f(y[4 * g + 3] - c3);
        if (MASK) { if (!(s0 + crow(4 * g, hi) < t)) a0 = 0.f; if (!(s0 + crow(4 * g + 1, hi) < t)) a1 = 0.f; if (!(s0 + crow(4 * g + 2, hi) < t)) a2 = 0.f; if (!(s0 + crow(4 * g + 3, hi) < t)) a3 = 0.f; }
        y[4 * g] = a0; y[4 * g + 1] = a1; y[4 * g + 2] = a2; y[4 * g + 3] = a3; }
    return total;
}
constexpr int ATT_K = 0, ATT_V = 32768, ATT_STG = 65536, ATT_STG_W = 8320, ATT_FLAG = ATT_STG + 8 * ATT_STG_W;
constexpr float SB_THR = 127.f;

__device__ __forceinline__ void attn_epilogue(const f32x16 (&o)[2], LAS float* stg, float rs, const float* __restrict__ gain, const bf16* __restrict__ zrow, bf16* __restrict__ yrow, int r32, int hi) {
#pragma unroll
    for (int d0 = 0; d0 < 2; ++d0)
#pragma unroll
        for (int r = 0; r < 16; ++r) stg[crow(r, hi) * 65 + d0 * 32 + r32] = o[d0][r];
    __builtin_amdgcn_s_waitcnt(0xC07F); asm volatile("" ::: "memory");
    float v[32]; float ss = 0.f;
#pragma unroll
    for (int i = 0; i < 32; ++i) { v[i] = stg[r32 * 65 + hi * 32 + i] * rs; ss += v[i] * v[i]; }
    ss += __shfl_xor(ss, 32);
    const float rn = 1.f / sqrtf(ss * (1.f / 64.f) + EPS);
#pragma unroll
    for (int c = 0; c < 4; ++c) { const u32x4 zw = *(const u32x4*)(zrow + hi * 32 + c * 8); const f32x4 g0 = *(const f32x4*)(gain + hi * 32 + c * 8), g1 = *(const f32x4*)(gain + hi * 32 + c * 8 + 4);
        u32x4 ow;
        ow.x = cvtpk(v[8 * c] * rn * g0.x * siluf_(bflo(zw.x)), v[8 * c + 1] * rn * g0.y * siluf_(bfhi(zw.x)));
        ow.y = cvtpk(v[8 * c + 2] * rn * g0.z * siluf_(bflo(zw.y)), v[8 * c + 3] * rn * g0.w * siluf_(bfhi(zw.y)));
        ow.z = cvtpk(v[8 * c + 4] * rn * g1.x * siluf_(bflo(zw.z)), v[8 * c + 5] * rn * g1.y * siluf_(bfhi(zw.z)));
        ow.w = cvtpk(v[8 * c + 6] * rn * g1.z * siluf_(bflo(zw.w)), v[8 * c + 7] * rn * g1.w * siluf_(bfhi(zw.w)));
        *(u32x4*)(yrow + hi * 32 + c * 8) = ow; }
}

__device__ __forceinline__ void sb_unit(int b, int h, int qb, const bf16* __restrict__ U, const float* __restrict__ g_head, bf16* __restrict__ Y, ldsp lds) {
    const int tid = threadIdx.x, lane = tid & 63, r32 = lane & 31, hi = lane >> 5, wid = __builtin_amdgcn_readfirstlane(tid >> 6);
    const size_t row0 = (size_t)b * SEQ; const int q0 = qb * 256, qw = q0 + 32 * wid, t = qw + r32;
    LAS unsigned* flag = (LAS unsigned*)(lds + ATT_FLAG);
    const bf16* Kg = U + row0 * NU + UKS + h * 64; const bf16* Vg = U + row0 * NU + UVS + h * 64;
    bf16x8 qr[4];
#pragma unroll
    for (int d0 = 0; d0 < 4; ++d0) qr[d0] = *(const bf16x8*)(U + (row0 + t) * NU + UQS + h * 64 + d0 * 16 + hi * 8);
    f32x16 o[2];
#pragma unroll
    for (int i = 0; i < 16; ++i) { o[0][i] = 0.f; o[1][i] = 0.f; }
    float R = 0.f; bool done = false;
    const int my_jt = qw >> 6;
    if (tid < 8) flag[tid] = 0u;
#pragma unroll 1
    for (int jt = 4 * qb + 3; jt >= 0; --jt) {
        __syncthreads();
        { unsigned all = 1u;
#pragma unroll
          for (int i = 0; i < 8; ++i) all &= flag[i];
          if (all) break; }
        stage_kv(Kg + (size_t)jt * 64 * NU, Vg + (size_t)jt * 64 * NU, NU, lds + ATT_K, lds + ATT_V, wid, lane);
        __syncthreads();
        if (jt <= my_jt && !done) {
            bf16x8 pa[4]; f32x16 p; float t1, t0;
            qkt_half(p, lds + ATT_K, qr, 1, r32, hi);
#pragma unroll
            for (int i = 0; i < 16; ++i) p[i] *= 0.125f * LOG2E;
            if (jt == my_jt) t1 = sb_half<true>(p, R, jt * 64 + 32, t, hi); else t1 = sb_half<false>(p, R, jt * 64 + 32, t, hi);
            pa[2] = pack8(p, 0); pa[3] = pack8(p, 1);
            qkt_half(p, lds + ATT_K, qr, 0, r32, hi);
#pragma unroll
            for (int i = 0; i < 16; ++i) p[i] *= 0.125f * LOG2E;
            if (jt == my_jt) t0 = sb_half<true>(p, R + t1, jt * 64, t, hi); else t0 = sb_half<false>(p, R + t1, jt * 64, t, hi);
            pa[0] = pack8(p, 0); pa[1] = pack8(p, 1);
            R += t1 + t0;
            pv64(o, lds + ATT_V, pa, lane, hi);
            done = __all(R >= SB_THR) != 0;
        }
        if (lane == 0 && done) flag[wid] = 1u;
    }
    attn_epilogue(o, (LAS float*)(lds + ATT_STG + wid * ATT_STG_W), 1.f, g_head + h * 64, U + (row0 + t) * NU + UZS + h * 64, Y + (row0 + t) * DM + YS + h * 64, r32, hi);
    __syncthreads();
}

__device__ __forceinline__ void mem_unit(int b, int h, int qb, const bf16* __restrict__ U, const bf16* __restrict__ KVM, const float* __restrict__ g_head, bf16* __restrict__ Y, ldsp lds) {
    const int tid = threadIdx.x, lane = tid & 63, r32 = lane & 31, hi = lane >> 5, wid = __builtin_amdgcn_readfirstlane(tid >> 6);
    const size_t row0 = (size_t)b * SEQ; const int t = qb * 256 + 32 * wid + r32;
    const bf16* Kg = KVM + (size_t)b * NMEM * 512 + h * 64; const bf16* Vg = Kg + 256;
#pragma unroll
    for (int jt = 0; jt < 4; ++jt) stage_kv(Kg + (size_t)jt * 64 * 512, Vg + (size_t)jt * 64 * 512, 512, lds + ATT_K + jt * 8192, lds + ATT_V + jt * 8192, wid, lane);
    bf16x8 qr[4];
#pragma unroll
    for (int d0 = 0; d0 < 4; ++d0) qr[d0] = *(const bf16x8*)(U + (row0 + t) * NU + UQC + h * 64 + d0 * 16 + hi * 8);
    __syncthreads();
    float mx_ = -3.0e38f;
#pragma unroll 1
    for (int jt = 0; jt < 4; ++jt) { f32x16 p0, p1; qkt(p0, p1, lds + ATT_K + jt * 8192, qr, r32, hi);
#pragma unroll
        for (int i = 0; i < 16; ++i) mx_ = fmaxf(mx_, fmaxf(p0[i], p1[i])); }
    mx_ = fmaxf(mx_, __shfl_xor(mx_, 32));
    const float mc = mx_ * (0.125f * LOG2E);
    f32x16 o[2];
#pragma unroll
    for (int i = 0; i < 16; ++i) { o[0][i] = 0.f; o[1][i] = 0.f; }
    float l = 0.f;
#pragma unroll 1
    for (int jt = 0; jt < 4; ++jt) { f32x16 p0, p1; qkt(p0, p1, lds + ATT_K + jt * 8192, qr, r32, hi);
#pragma unroll
        for (int i = 0; i < 16; ++i) { p0[i] = __builtin_amdgcn_exp2f(p0[i] * (0.125f * LOG2E) - mc); p1[i] = __builtin_amdgcn_exp2f(p1[i] * (0.125f * LOG2E) - mc); l += p0[i] + p1[i]; }
        bf16x8 pa[4]; pa[0] = pack8(p0, 0); pa[1] = pack8(p0, 1); pa[2] = pack8(p1, 0); pa[3] = pack8(p1, 1);
        pv64(o, lds + ATT_V + jt * 8192, pa, lane, hi); }
    l += __shfl_xor(l, 32);
    attn_epilogue(o, (LAS float*)(lds + ATT_STG + wid * ATT_STG_W), 1.f / l, g_head + h * 64, U + (row0 + t) * NU + UZC + h * 64, Y + (row0 + t) * DM + YC + h * 64, r32, hi);
    __syncthreads();
}
}

#ifndef USE_MFMA_SB
#define USE_MFMA_SB 1
#endif
#ifndef USE_MFMA_MEM
#define USE_MFMA_MEM 1
#endif

constexpr int LDS_BYTES = 147456;
struct Args {
    const float *x, *mem, *g_pre, *w_in, *conv_w, *conv_b, *i_bias, *f_bias, *g_mh, *g_sh, *g_ch, *g_mem, *w_kv, *w_out, *g_post;
    float* out; unsigned char* ws;
};

__global__ void __launch_bounds__(512, 2) hybrid_fwd(Args a) {
    extern __shared__ __attribute__((aligned(16))) unsigned char lds[];
    cg::grid_group grid = cg::this_grid();
    const int tid = threadIdx.x, lane = tid & 63, wave = __builtin_amdgcn_readfirstlane(tid >> 6);
    const int nb = (int)gridDim.x, bx = (int)blockIdx.x;
    unsigned char* ws = a.ws;
    bf16* WIN = (bf16*)(ws + WS_WIN); bf16* WO = (bf16*)(ws + WS_WO); bf16* WKV = (bf16*)(ws + WS_WKV); float* G = (float*)(ws + WS_G);
    bf16* MEMN = (bf16*)(ws + WS_MEMN); bf16* KVM = (bf16*)(ws + WS_KVM); bf16* XN = (bf16*)(ws + WS_XN); bf16* Y = (bf16*)(ws + WS_Y); bf16* U = (bf16*)(ws + WS_U);

    { ProArgs pa{a.x, a.mem, a.g_pre, a.w_in, a.i_bias, a.f_bias, a.g_mem, a.w_kv, a.w_out, WIN, WO, WKV, XN, MEMN, G};
      phase_prologue(pa, (float*)lds, nb, bx); }
    grid.sync();

    { pg8::Gemm g{XN, WIN, M, NU, DM}; pg8::StaticOrder S; S.init(M, NU, nb, bx);
      pg8::EpiBf16<0> E{U, NU, nullptr, 0, 0, 1.f};
      pg8::gemm_phase<pg8::EpiBf16<0>, pg8::StaticOrder, true, true>((PG8_LAS unsigned char*)lds, g, S, E); }
    { pg8::Gemm g{MEMN, WKV, MMEM, 512, DM}; pg8::StaticOrder S; S.init(MMEM, 512, nb, bx);
      pg8::EpiBf16<0> E{KVM, 512, nullptr, 0, 0, 1.f};
      pg8::gemm_phase<pg8::EpiBf16<0>, pg8::StaticOrder, true, true>((PG8_LAS unsigned char*)lds, g, S, E); }
    grid.sync();

    {
        for (int u = bx; u < 128; u += nb) mlstm_naive_unit(u >> 2, u & 3, U, G, a.conv_w, a.conv_b, a.g_mh, Y, (float*)lds);
#if USE_MFMA_SB
        for (int u = bx; u < 1024; u += nb) mx::sb_unit((u & 127) >> 2, u & 3, u >> 7, U, a.g_sh, Y, (mx::ldsp)lds);
#else
        for (int wu = bx * 8 + wave; wu < 4096; wu += nb * 8) sb_naive_wave(wu, U, a.g_sh, Y, lane);
#endif
#if USE_MFMA_MEM
        for (int u = bx; u < 1024; u += nb) mx::mem_unit((u & 127) >> 2, u & 3, u >> 7, U, KVM, a.g_ch, Y, (mx::ldsp)lds);
#else
        for (int wu = bx * 8 + wave; wu < 4096; wu += nb * 8) mem_naive_wave(wu, U, KVM, a.g_ch, Y, lane);
#endif
    }
    grid.sync();

    { pg8::Gemm g{Y, WO, M, DM, DM}; pg8::StaticOrder S; S.init(M, DM, nb, bx);
      pg8::EpiF32 E{a.out, DM};
      pg8::gemm_phase<pg8::EpiF32, pg8::StaticOrder, true, true>((PG8_LAS unsigned char*)lds, g, S, E); }
    grid.sync();

    final_rows(a.x, a.g_post, a.out, bx * 8 + wave, nb * 8, lane);
}

extern "C" void kernel_launch(void* const* d_in, const int* in_sizes, int n_in, void* d_out, int out_size, void* d_ws, size_t ws_size, hipStream_t stream) {
    static int grid_blocks = 0;
    if (grid_blocks == 0) {
        if (n_in != 15 || out_size != M * DM || ws_size < WS_END) { fprintf(stderr, "kernel_launch: unexpected shapes (n_in %d out %d ws %zu)\n", n_in, out_size, ws_size); grid_blocks = -1; return; }
        int dev = 0, cus = 0, per_cu = 0;
        (void)hipGetDevice(&dev); (void)hipDeviceGetAttribute(&cus, hipDeviceAttributeMultiprocessorCount, dev);
        if (hipFuncSetAttribute((const void*)hybrid_fwd, hipFuncAttributeMaxDynamicSharedMemorySize, LDS_BYTES) != hipSuccess) { fprintf(stderr, "kernel_launch: hipFuncSetAttribute failed\n"); grid_blocks = -1; return; }
        if (hipOccupancyMaxActiveBlocksPerMultiprocessor(&per_cu, (const void*)hybrid_fwd, 512, LDS_BYTES) != hipSuccess || per_cu < 1) { fprintf(stderr, "kernel_launch: occupancy query says %d blocks per CU\n", per_cu); per_cu = 1; }
        (void)hipGetLastError();
        if (per_cu > 1) per_cu = 1;
        grid_blocks = cus * per_cu;
    }
    if (grid_blocks < 0) return;
    Args a{};
    a.x = (const float*)d_in[0]; a.mem = (const float*)d_in[1]; a.g_pre = (const float*)d_in[2]; a.w_in = (const float*)d_in[3];
    a.conv_w = (const float*)d_in[4]; a.conv_b = (const float*)d_in[5]; a.i_bias = (const float*)d_in[6]; a.f_bias = (const float*)d_in[7];
    a.g_mh = (const float*)d_in[8]; a.g_sh = (const float*)d_in[9]; a.g_ch = (const float*)d_in[10]; a.g_mem = (const float*)d_in[11];
    a.w_kv = (const float*)d_in[12]; a.w_out = (const float*)d_in[13]; a.g_post = (const float*)d_in[14];
    a.out = (float*)d_out; a.ws = (unsigned char*)d_ws;
    void* args[] = {&a};
    hipError_t e = hipLaunchCooperativeKernel((const void*)hybrid_fwd, dim3(grid_blocks), dim3(512), args, LDS_BYTES, stream);
    if (e != hipSuccess) fprintf(stderr, "kernel_launch: cooperative launch failed: %s (grid %d)\n", hipGetErrorString(e), grid_blocks);
}
```

```cpp
#include <hip/hip_runtime.h>
#include <hip/hip_cooperative_groups.h>
#include <cstdio>
#include <cstdint>
namespace cg = cooperative_groups;
namespace pg8 {
#define PG8_LAS __attribute__((address_space(3)))
typedef unsigned short bf16_t;
typedef short bf16x8 __attribute__((ext_vector_type(8)));
typedef float f32x4 __attribute__((ext_vector_type(4)));
typedef unsigned u32x4 __attribute__((ext_vector_type(4)));
constexpr int BM = 256, BK = 64, HALF = 128, HTB = HALF * BK * 2  , STAGE_BYTES = 8 * HTB, NXCD = 8, WGM = 8;

__host__ __device__ __forceinline__ int lds_byte(int r, int c) { const int st = (r >> 4) * 2 + (c >> 5), rr = r & 15, cc = c & 31, ob = rr * 64 + cc * 2; return st * 1024 + (ob ^ (((ob >> 9) & 1) << 5)); }
__host__ __device__ __forceinline__ void stage_rc(int b, int& R, int& C) { const int st = b / 1024, sb = b % 1024, swz = sb ^ (((sb >> 9) & 1) << 5); R = (st >> 1) * 16 + swz / 64; C = (st & 1) * 32 + (swz % 64) / 2; }
__host__ __device__ __forceinline__ int perm32(int rho) { const int n = rho >> 4, i = rho & 15; return 8 * (i >> 2) + 4 * n + (i & 3); }

struct Unit { int pm, pn; };
struct Gemm { const bf16_t* A; const bf16_t* Bt; int M, N, K; };

struct StaticOrder {
    int nM, nN, nwg, G, c;
    __host__ __device__ void init(int M, int N, int G_, int c_) { nM = M / BM; nN = N / BM; nwg = nM * nN; G = G_; c = c_; }
    __host__ __device__ bool next(int i, Unit& u) const {
        const long L = (long)i * G + c; if (L >= nwg) return false;
        int wgid = (int)L; { const int q = nwg / NXCD, r = nwg % NXCD, xcd = wgid % NXCD, off = wgid / NXCD; wgid = (xcd < r ? xcd * (q + 1) : r * (q + 1) + (xcd - r) * q) + off; }
        const int nig = WGM * nN, gid = wgid / nig, fm = gid * WGM, gsz = (nM - fm) < WGM ? (nM - fm) : WGM;
        u.pm = fm + ((wgid % nig) % gsz); u.pn = (wgid % nig) / gsz; return true;
    }
    __device__ __forceinline__ void a_ready(const Unit&) const {}
    __device__ __forceinline__ void done(const Unit&) const {}
};

__device__ __forceinline__ unsigned cvt_pk_bf16(float lo, float hi) { unsigned r; asm volatile("v_cvt_pk_bf16_f32 %0, %1, %2" : "=v"(r) : "v"(lo), "v"(hi)); return r; }
typedef float f32x2 __attribute__((ext_vector_type(2)));
__device__ __forceinline__ f32x2 gelu_pk(f32x2 v) {
    const f32x2 av = __builtin_elementwise_abs(v), d = av * 0.2316418882f + 1.0f;
    f32x2 t; t.x = __builtin_amdgcn_rcpf(d.x); t.y = __builtin_amdgcn_rcpf(d.y);
    f32x2 q = t * 0.5307027145f + (-0.7265760135f); q = q * t + 0.7107068705f; q = q * t + (-0.142248368f); q = q * t + 0.127414796f; q = q * t;
    const f32x2 s = (v * v) * (-0.72134752044f);
    f32x2 e; e.x = __builtin_amdgcn_exp2f(s.x); e.y = __builtin_amdgcn_exp2f(s.y);
    const f32x2 m = v * (q * e), r = v - m;
    f32x2 o; o.x = v.x < 0.f ? m.x : r.x; o.y = v.y < 0.f ? m.y : r.y; return o;
}

template <int ACT  > struct EpiBf16 {
    static constexpr bool PERM = true, AFTER_DRAIN = false; static_assert(ACT == 0 || ACT == 1, "EpiBf16: ACT is 0 (none) or 1 (gelu_pk)");
    bf16_t* O; int ldc; const float* bias; int split_cols; size_t split_stride; float scale0;
    __device__ __forceinline__ void operator()(const f32x4 (&acc)[2][2][4][2], const Unit& u, int wr, int wc, int fr, int fq) const {
        const int row0 = u.pm * BM + wr * 64 + fr; int colt = u.pn * BM; bf16_t* base = O;
        float sc = 1.f; if (split_cols) { const int t = colt / split_cols; base += (size_t)t * split_stride; colt -= t * split_cols; if (t == 0) sc = scale0; }
        const int col0 = colt + wc * 32 + 8 * fq, bcol0 = u.pn * BM + wc * 32 + 8 * fq;
        f32x4 bv[2][2];
#pragma unroll
        for (int bj = 0; bj < 2; ++bj)
#pragma unroll
            for (int n = 0; n < 2; ++n) bv[bj][n] = bias ? *(const f32x4*)(bias + bcol0 + bj * HALF + 4 * n) : (f32x4){0.f, 0.f, 0.f, 0.f};
#pragma unroll
        for (int ai = 0; ai < 2; ++ai)
#pragma unroll
            for (int m = 0; m < 4; ++m) { bf16_t* rowp = base + (size_t)(row0 + ai * HALF + m * 16) * ldc + col0;
#pragma unroll
                for (int bj = 0; bj < 2; ++bj) { f32x4 v0 = acc[ai][bj][m][0] + bv[bj][0], v1 = acc[ai][bj][m][1] + bv[bj][1];
                    if (ACT == 1) { f32x2 a = gelu_pk((f32x2){v0[0], v0[1]}), b = gelu_pk((f32x2){v0[2], v0[3]}), c = gelu_pk((f32x2){v1[0], v1[1]}), d = gelu_pk((f32x2){v1[2], v1[3]});
                        v0 = (f32x4){a.x, a.y, b.x, b.y}; v1 = (f32x4){c.x, c.y, d.x, d.y}; }
                    v0 = v0 * sc; v1 = v1 * sc; u32x4 w; w.x = cvt_pk_bf16(v0[0], v0[1]); w.y = cvt_pk_bf16(v0[2], v0[3]); w.z = cvt_pk_bf16(v1[0], v1[1]); w.w = cvt_pk_bf16(v1[2], v1[3]);
                    *(u32x4*)(rowp + bj * HALF) = w; } }
    }
};
struct EpiF32 {
    static constexpr bool PERM = false, AFTER_DRAIN = false;
    float* O; int ldc;
    __device__ __forceinline__ void operator()(const f32x4 (&acc)[2][2][4][2], const Unit& u, int wr, int wc, int fr, int fq) const {
        const int col0 = u.pn * BM + wc * 32 + 4 * fq;
#pragma unroll
        for (int ai = 0; ai < 2; ++ai)
#pragma unroll
            for (int m = 0; m < 4; ++m) { const int r = ai * HALF + wr * 64 + m * 16 + fr; float* rowp = O + (size_t)(u.pm * BM + r) * ldc + col0;
#pragma unroll
                for (int bj = 0; bj < 2; ++bj)
#pragma unroll
                    for (int n = 0; n < 2; ++n) *(f32x4*)(rowp + bj * HALF + n * 16) = acc[ai][bj][m][n]; }
    }
};
template <class Epi, class Sched, bool ALIGN_EPI = false, bool SP2 = false>
__device__ __forceinline__ void gemm_phase(PG8_LAS unsigned char* lds, const Gemm g, const Sched& S, const Epi& E) {
    const int tid = threadIdx.x, wid = __builtin_amdgcn_readfirstlane(tid >> 6), lane = tid & 63, wr = wid >> 2, wc = wid & 3, fr = lane & 15, fq = lane >> 4;
    const int K = g.K, nt = K / BK;
    unsigned voffA[2], voffB[2];
#pragma unroll
    for (int i = 0; i < 2; ++i) { int R, C; stage_rc(tid * 16 + i * 8192, R, C); const int Rb = Epi::PERM ? ((R & ~31) + perm32(R & 31)) : R;
        voffA[i] = (unsigned)(R * K + C) * 2u; voffB[i] = (unsigned)(Rb * K + C) * 2u; }
    const size_t kstep = (size_t)(BK * 2);
    const size_t hstep = (size_t)HALF * K * 2;
    const size_t tstep = 2 * hstep;
    const unsigned ldsw = (unsigned)wid * 1024u;
    const int aoff = lds_byte(wr * 64 + fr, fq * 8), boff = lds_byte(wc * 32 + fr, fq * 8);
#define PG8_SA(b, h) (((b) * 2 + (h)) * HTB)
#define PG8_SB(b, h) ((4 + (b) * 2 + (h)) * HTB)
#define PG8_STAGE(bufoff, gbase, voff) do { _Pragma("unroll") for (int _i = 0; _i < 2; ++_i) \
        __builtin_amdgcn_global_load_lds((const unsigned*)((const char*)(gbase) + (voff)[_i]), (PG8_LAS unsigned*)(lds + (bufoff) + ldsw + _i * 8192), 16, 0, 0); } while (0)
#define PG8_LDA(dst, b, h) do { _Pragma("unroll") for (int m = 0; m < 4; ++m) _Pragma("unroll") for (int k = 0; k < 2; ++k) dst[m][k] = *(const PG8_LAS bf16x8*)(lds + PG8_SA(b, h) + aoff + m * 2048 + k * 1024); } while (0)
#define PG8_LDB(dst, b, h) do { _Pragma("unroll") for (int n = 0; n < 2; ++n) _Pragma("unroll") for (int k = 0; k < 2; ++k) dst[n][k] = *(const PG8_LAS bf16x8*)(lds + PG8_SB(b, h) + boff + n * 2048 + k * 1024); } while (0)
#define PG8_MMA(ai, bj, At, Bt) do { __builtin_amdgcn_s_setprio(1); _Pragma("unroll") for (int m = 0; m < 4; ++m) _Pragma("unroll") for (int n = 0; n < 2; ++n) _Pragma("unroll") for (int k = 0; k < 2; ++k) \
        acc[ai][bj][m][n] = __builtin_amdgcn_mfma_f32_16x16x32_bf16(Bt[n][k], At[m][k], acc[ai][bj][m][n], 0, 0, 0); __builtin_amdgcn_s_setprio(0); } while (0)
#define PG8_WAIT_V(n) asm volatile("s_waitcnt vmcnt(" #n ")" ::: "memory")
#define PG8_WAIT_L(n) asm volatile("s_waitcnt lgkmcnt(" #n ")" ::: "memory")
#define PG8_BAR __builtin_amdgcn_s_barrier()
#define PG8_SCHED __builtin_amdgcn_sched_barrier(0)
    Unit cur, nxt; int ui = 0;
    if (!S.next(0, cur)) return;
    f32x4 acc[2][2][4][2];
#pragma unroll
    for (int a = 0; a < 2; ++a)
#pragma unroll
        for (int b = 0; b < 2; ++b)
#pragma unroll
            for (int m = 0; m < 4; ++m)
#pragma unroll
                for (int n = 0; n < 2; ++n) acc[a][b][m][n] = (f32x4){0.f, 0.f, 0.f, 0.f};
    bf16x8 At[4][2], B0[2][2], B1[2][2];
    const char* cA = (const char*)g.A + (size_t)cur.pm * tstep; const char* cB = (const char*)g.Bt + (size_t)cur.pn * tstep;
    S.a_ready(cur);
    if constexpr (SP2) {
        PG8_STAGE(PG8_SB(0, 0), cB, voffB); PG8_STAGE(PG8_SB(0, 1), cB + hstep, voffB); PG8_STAGE(PG8_SA(0, 0), cA, voffA); PG8_STAGE(PG8_SA(0, 1), cA + hstep, voffA);
        if (wr == 1) PG8_BAR;
        PG8_WAIT_V(2); PG8_BAR;
        PG8_STAGE(PG8_SB(1, 0), cB + kstep, voffB); PG8_STAGE(PG8_SA(1, 0), cA + kstep, voffA); PG8_STAGE(PG8_SB(1, 1), cB + hstep + kstep, voffB);
        PG8_WAIT_V(6); PG8_BAR;
    } else {
        PG8_STAGE(PG8_SB(0, 0), cB, voffB); PG8_STAGE(PG8_SA(0, 0), cA, voffA); PG8_STAGE(PG8_SB(0, 1), cB + hstep, voffB); PG8_STAGE(PG8_SA(0, 1), cA + hstep, voffA);
        if (wr == 1) PG8_BAR;
        PG8_WAIT_V(4); PG8_BAR;
        PG8_STAGE(PG8_SB(1, 0), cB + kstep, voffB); PG8_STAGE(PG8_SA(1, 0), cA + kstep, voffA); PG8_STAGE(PG8_SB(1, 1), cB + hstep + kstep, voffB);
        PG8_WAIT_V(6); PG8_BAR;
    }
    for (;;) {
        const bool has_next = S.next(ui + 1, nxt);
        const char* nA = has_next ? (const char*)g.A + (size_t)nxt.pm * tstep : cA; const char* nB = has_next ? (const char*)g.Bt + (size_t)nxt.pn * tstep : cB;
        for (int t = 0; t < nt; t += 2) {
            const bool last = (t == nt - 2);
            const char* a1 = cA + (size_t)(t + 1) * kstep;
            const char* a2 = last ? nA : cA + (size_t)(t + 2) * kstep; const char* b2 = last ? nB : cB + (size_t)(t + 2) * kstep;
            const char* a3 = a2 + kstep; const char* b3 = b2 + kstep;
            if (last && has_next) S.a_ready(nxt);
            if constexpr (SP2) {
            PG8_LDB(B0, 0, 0); PG8_LDB(B1, 0, 1); PG8_SCHED; PG8_LDA(At, 0, 0); PG8_STAGE(PG8_SA(1, 1), a1 + hstep, voffA);
            PG8_WAIT_V(8); PG8_WAIT_L(0); PG8_BAR; PG8_MMA(0, 0, At, B0); PG8_MMA(0, 1, At, B1); PG8_BAR; PG8_SCHED;
            PG8_LDA(At, 0, 1); PG8_STAGE(PG8_SB(0, 0), b2, voffB); PG8_STAGE(PG8_SB(0, 1), b2 + hstep, voffB); PG8_STAGE(PG8_SA(0, 0), a2, voffA);
            PG8_WAIT_V(8); PG8_WAIT_L(0); PG8_BAR; PG8_MMA(1, 0, At, B0); PG8_MMA(1, 1, At, B1); PG8_BAR; PG8_SCHED;
            PG8_LDB(B0, 1, 0); PG8_LDB(B1, 1, 1); PG8_SCHED; PG8_LDA(At, 1, 0); PG8_STAGE(PG8_SA(0, 1), a2 + hstep, voffA);
            PG8_WAIT_V(8); PG8_WAIT_L(0); PG8_BAR; PG8_MMA(0, 0, At, B0); PG8_MMA(0, 1, At, B1); PG8_BAR; PG8_SCHED;
            PG8_LDA(At, 1, 1); PG8_STAGE(PG8_SB(1, 0), b3, voffB); PG8_STAGE(PG8_SB(1, 1), b3 + hstep, voffB); PG8_STAGE(PG8_SA(1, 0), a3, voffA);
            PG8_WAIT_V(8); PG8_WAIT_L(0); PG8_BAR; PG8_MMA(1, 0, At, B0); PG8_MMA(1, 1, At, B1); PG8_BAR; PG8_SCHED;
            } else {
            PG8_LDB(B0, 0, 0); PG8_SCHED; PG8_LDA(At, 0, 0); PG8_STAGE(PG8_SA(1, 1), a1 + hstep, voffA);
            PG8_WAIT_L(8); PG8_BAR; PG8_WAIT_L(0); PG8_MMA(0, 0, At, B0); PG8_BAR; PG8_SCHED;
            PG8_LDB(B1, 0, 1); PG8_STAGE(PG8_SB(0, 0), b2, voffB);
            PG8_BAR; PG8_WAIT_L(0); PG8_MMA(0, 1, At, B1); PG8_BAR;
            PG8_LDA(At, 0, 1); PG8_STAGE(PG8_SA(0, 0), a2, voffA);
            PG8_BAR; PG8_WAIT_L(0); PG8_MMA(1, 0, At, B0); PG8_BAR; PG8_SCHED;
            PG8_STAGE(PG8_SB(0, 1), b2 + hstep, voffB);
            PG8_WAIT_V(6); PG8_BAR; PG8_MMA(1, 1, At, B1); PG8_BAR;
            PG8_LDB(B0, 1, 0); PG8_SCHED; PG8_LDA(At, 1, 0); PG8_STAGE(PG8_SA(0, 1), a2 + hstep, voffA);
            PG8_WAIT_L(8); PG8_BAR; PG8_WAIT_L(0); PG8_MMA(0, 0, At, B0); PG8_BAR; PG8_SCHED;
            PG8_LDB(B1, 1, 1); PG8_STAGE(PG8_SB(1, 0), b3, voffB);
            PG8_BAR; PG8_WAIT_L(0); PG8_MMA(0, 1, At, B1); PG8_BAR;
            PG8_LDA(At, 1, 1); PG8_STAGE(PG8_SA(1, 0), a3, voffA);
            PG8_BAR; PG8_WAIT_L(0); PG8_MMA(1, 0, At, B0); PG8_BAR; PG8_SCHED;
            PG8_STAGE(PG8_SB(1, 1), b3 + hstep, voffB);
            PG8_WAIT_V(6); PG8_BAR; PG8_MMA(1, 1, At, B1); PG8_BAR;
            }
        }
        if constexpr (ALIGN_EPI) { if (wr == 0) PG8_BAR; }
        if constexpr (!Epi::AFTER_DRAIN) { E(acc, cur, wr, wc, fr, fq); S.done(cur); }
        if (!has_next) break;
#pragma unroll
        for (int a = 0; a < 2; ++a)
#pragma unroll
            for (int b = 0; b < 2; ++b)
#pragma unroll
                for (int m = 0; m < 4; ++m)
#pragma unroll
                    for (int n = 0; n < 2; ++n) acc[a][b][m][n] = (f32x4){0.f, 0.f, 0.f, 0.f};
        cur = nxt; cA = nA; cB = nB; ++ui;
        if constexpr (ALIGN_EPI) { if (wr == 1) PG8_BAR; }
    }
    PG8_WAIT_V(0);
    if constexpr (!ALIGN_EPI) { if (wr == 0) PG8_BAR; }
    PG8_BAR;
    if constexpr (Epi::AFTER_DRAIN) { E.fused(acc, cur, wr, wc, fr, fq, lds, wid, lane); S.done(cur); }
#undef PG8_SA
#undef PG8_SB
#undef PG8_STAGE
#undef PG8_LDA
#undef PG8_LDB
#undef PG8_MMA
#undef PG8_WAIT_V
#undef PG8_WAIT_L
#undef PG8_BAR
#undef PG8_SCHED
}
}

constexpr int BATCH = 32, SEQ = 2048, DM = 1024, M = BATCH * SEQ;
constexpr int DIN = 4104, NU = 4096;
constexpr int NMEM = 256, MMEM = BATCH * NMEM;
constexpr int UQM = 0, UKM = 512, UVM = 1024, UOM = 1536, UZM = 2048, UQS = 2560, UKS = 2816, UVS = 3072, UZS = 3328, UQC = 3584, UZC = 3840;
constexpr int WIF = 2560;
constexpr float EPS = 1e-6f;
constexpr int YM = 0, YS = 512, YC = 768;

constexpr size_t MiB = 1u << 20;
constexpr size_t WS_CTL = 0, CTL_ZERO_BYTES = 1 * MiB;
constexpr size_t WS_WIN = 2 * MiB;
constexpr size_t WS_WO = 10 * MiB;
constexpr size_t WS_WKV = 12 * MiB;
constexpr size_t WS_G = 14 * MiB;
constexpr size_t WS_MEMN = 16 * MiB;
constexpr size_t WS_KVM = 32 * MiB;
constexpr size_t WS_XN = 64 * MiB;
constexpr size_t WS_Y = 64 * MiB;
constexpr size_t WS_U = 192 * MiB;
constexpr size_t WS_END = 704 * MiB;

typedef unsigned short bf16;
typedef float f32x4 __attribute__((ext_vector_type(4)));
typedef unsigned v4u __attribute__((ext_vector_type(4)));
typedef unsigned v2u __attribute__((ext_vector_type(2)));
#define LAS __attribute__((address_space(3)))

__device__ __forceinline__ unsigned f2bf(float f) { unsigned u = __builtin_bit_cast(unsigned, f); return (u + 0x7fffu + ((u >> 16) & 1u)) >> 16; }
__device__ __forceinline__ unsigned pk2(float lo, float hi) { return f2bf(lo) | (f2bf(hi) << 16); }
__device__ __forceinline__ float bf2f(unsigned h) { return __builtin_bit_cast(float, h << 16); }
__device__ __forceinline__ float bflo(unsigned w) { return __builtin_bit_cast(float, w << 16); }
__device__ __forceinline__ float bfhi(unsigned w) { return __builtin_bit_cast(float, w & 0xffff0000u); }
__device__ __forceinline__ float wave_sum(float v) {
#pragma unroll
    for (int o = 1; o < 64; o <<= 1) v += __shfl_xor(v, o);
    return v;
}
__device__ __forceinline__ float sigmoidf_(float x) { return 1.f / (1.f + __expf(-x)); }
__device__ __forceinline__ float siluf_(float x) { return x / (1.f + __expf(-x)); }

__device__ __forceinline__ void transpose_item(const float* W, int Nsrc, int K, bf16* WT, const float* gk, float* scr, int kb, int n0_dst, int n0_src, int lane) {
    const int k0 = 64 * kb;
#pragma unroll 8
    for (int i = 0; i < 32; ++i) { const int kk = 2 * i + (lane >> 5); const float g = gk ? gk[k0 + kk] : 1.f; scr[kk * 33 + (lane & 31)] = g * W[(size_t)(k0 + kk) * Nsrc + n0_src + (lane & 31)]; }
    __builtin_amdgcn_s_waitcnt(0xC07F); asm volatile("" ::: "memory");
    const int c = lane & 7;
#pragma unroll
    for (int j = 0; j < 4; ++j) { const int n = (lane >> 3) + 8 * j; const float* s = scr + (8 * c) * 33 + n;
        v4u o; o.x = pk2(s[0 * 33], s[1 * 33]); o.y = pk2(s[2 * 33], s[3 * 33]); o.z = pk2(s[4 * 33], s[5 * 33]); o.w = pk2(s[6 * 33], s[7 * 33]);
        *(v4u*)(WT + (size_t)(n0_dst + n) * K + k0 + 8 * c) = o; }
    __builtin_amdgcn_s_waitcnt(0xC07F); asm volatile("" ::: "memory");
}

struct ProArgs {
    const float *x, *mem, *g_pre, *w_in, *i_bias, *f_bias, *g_mem, *w_mem_kv, *w_out;
    bf16 *WIN, *WO, *WKV, *XN, *MEMN; float* G;
};

template <bool GATES>
__device__ __forceinline__ void row_item(const float* xrow, bf16* orow, float* grow, const float* wif, const float* i_bias, const float* f_bias, int h_unused, int lane) {
    const f32x4* xr = (const f32x4*)xrow + lane;
    f32x4 v[4]; float s = 0.f;
#pragma unroll
    for (int j = 0; j < 4; ++j) { v[j] = xr[64 * j]; s += (v[j].x * v[j].x + v[j].y * v[j].y) + (v[j].z * v[j].z + v[j].w * v[j].w); }
    const float rstd = 1.f / sqrtf(wave_sum(s) * (1.f / DM) + EPS);
#pragma unroll
    for (int j = 0; j < 4; ++j) v[j] = v[j] * rstd;
    unsigned long long* o8 = (unsigned long long*)orow + lane;
#pragma unroll
    for (int j = 0; j < 4; ++j) o8[64 * j] = (unsigned long long)pk2(v[j].x, v[j].y) | ((unsigned long long)pk2(v[j].z, v[j].w) << 32);
    if (GATES) {
        float a[8];
#pragma unroll
        for (int g = 0; g < 8; ++g) a[g] = 0.f;
#pragma unroll
        for (int j = 0; j < 4; ++j)
#pragma unroll
            for (int c = 0; c < 4; ++c) { const int k = 4 * (lane + 64 * j) + c; const float xv = v[j][c]; const f32x4 w0 = *(const f32x4*)(wif + k * 8), w1 = *(const f32x4*)(wif + k * 8 + 4);
                a[0] += xv * w0.x; a[1] += xv * w0.y; a[2] += xv * w0.z; a[3] += xv * w0.w; a[4] += xv * w1.x; a[5] += xv * w1.y; a[6] += xv * w1.z; a[7] += xv * w1.w; }
#pragma unroll
        for (int g = 0; g < 8; ++g) a[g] = wave_sum(a[g]);
        float val = a[0];
#pragma unroll
        for (int g = 1; g < 8; ++g) if (lane == g) val = a[g];
        if (lane < 4) grow[lane] = val + i_bias[lane];
        else if (lane < 8) { const float xx = val + f_bias[lane - 4]; grow[lane] = fminf(xx, 0.f) - log1pf(expf(-fabsf(xx))); }
    }
}

__device__ __forceinline__ void phase_prologue(const ProArgs& a, float* sh, int nblocks, int block) {
    const int tid = threadIdx.x, lane = tid & 63, wave = tid >> 6;
    float* scr = sh + wave * 2112; float* wif = sh + 8 * 2112;
    for (int i = tid; i < 8192; i += 512) { const int k = i >> 3, g = i & 7; wif[i] = a.g_pre[k] * a.w_in[(size_t)k * DIN + WIF + g]; }
    __syncthreads();
    const int gw = block * 8 + wave, NGW = nblocks * 8;
    constexpr int I_IN = 16 * 128, I_O = 16 * 32, I_KV = 16 * 16, NIT = I_IN + I_O + I_KV;
    for (int it = gw; it < NIT; it += NGW) {
        int r = it;
        if (r < I_IN) { const int kb = r / 128, nb = r % 128, n0 = 32 * nb; transpose_item(a.w_in, DIN, DM, a.WIN, a.g_pre, scr, kb, n0, n0 + (n0 >= WIF ? 8 : 0), lane); continue; } r -= I_IN;
        if (r < I_O) { const int kb = r / 32, nb = r % 32; transpose_item(a.w_out, DM, DM, a.WO, nullptr, scr, kb, 32 * nb, 32 * nb, lane); continue; } r -= I_O;
        { const int kb = r / 16, nb = r % 16; transpose_item(a.w_mem_kv, 512, DM, a.WKV, a.g_mem, scr, kb, 32 * nb, 32 * nb, lane); }
    }
    for (int m = gw; m < M; m += NGW) row_item<true>(a.x + (size_t)m * DM, a.XN + (size_t)m * DM, a.G + (size_t)m * 8, wif, a.i_bias, a.f_bias, 0, lane);
    for (int m = gw; m < MMEM; m += NGW) row_item<false>(a.mem + (size_t)m * DM, a.MEMN + (size_t)m * DM, nullptr, wif, nullptr, nullptr, 0, lane);
}

__device__ __forceinline__ void mlstm_naive_unit(int b, int h, const bf16* __restrict__ U, const float* __restrict__ G, const float* __restrict__ conv_w, const float* __restrict__ conv_b,
                                                 const float* __restrict__ g_head, bf16* __restrict__ Y, float* shf) {
    float (*qs)[128] = (float (*)[128])shf; float (*ks)[128] = (float (*)[128])(shf + 2048); float (*vs)[128] = (float (*)[128])(shf + 4096); float (*s_num)[16][128] = (float (*)[16][128])(shf + 6144);
    float (*s_den)[16] = (float (*)[16])(shf + 10240); float* s_fg = shf + 10272; float* s_ig = shf + 10288; float* s_em = shf + 10304;
    const int tid = threadIdx.x, lane = tid & 63, wave = tid >> 6;
    const size_t row0 = (size_t)b * SEQ;
    float C[64];
#pragma unroll
    for (int d = 0; d < 64; ++d) C[d] = 0.f;
    float m = 0.f;
    float wq[4], wk[4], bq = 0.f, bk = 0.f;
    const int ce = tid & 127, dh = (tid >> 7) & 1;
#pragma unroll
    for (int j = 0; j < 4; ++j) { wq[j] = conv_w[j * 1024 + h * 128 + ce]; wk[j] = conv_w[j * 1024 + 512 + h * 128 + ce]; }
    bq = conv_b[h * 128 + ce]; bk = conv_b[512 + h * 128 + ce];
    for (int t0 = 0; t0 < SEQ; t0 += 16) {
        if (tid < 128) {
#pragma unroll 1
            for (int s = 0; s < 16; ++s) {
                float aq = bq, ak = bk;
#pragma unroll
                for (int j = 0; j < 4; ++j) { const int t = t0 + s - 3 + j;
                    if (t >= 0) { aq += wq[j] * bf2f(U[(row0 + t) * NU + UQM + h * 128 + tid]); ak += wk[j] * bf2f(U[(row0 + t) * NU + UKM + h * 128 + tid]); } }
                qs[s][tid] = siluf_(aq); ks[s][tid] = siluf_(ak) * 0.08838834764831845f;
                vs[s][tid] = bf2f(U[(row0 + t0 + s) * NU + UVM + h * 128 + tid]);
            }
        } else if (tid == 258) {
#pragma unroll 1
            for (int s = 0; s < 16; ++s) { const float ip = G[(row0 + t0 + s) * 8 + h], lf = G[(row0 + t0 + s) * 8 + 4 + h]; const float mn = fmaxf(lf + m, ip);
                s_fg[s] = expf(lf + m - mn); s_ig[s] = expf(ip - mn); s_em[s] = expf(-mn); m = mn; }
        }
        __syncthreads();
        if (tid < 258) {
#pragma unroll 1
            for (int s = 0; s < 16; ++s) { const float f = s_fg[s], av = s_ig[s] * (tid < 256 ? vs[s][ce] : 1.f); float num = 0.f;
#pragma unroll
                for (int d = 0; d < 64; d += 4) { const f32x4 k4 = *(const f32x4*)&ks[s][64 * dh + d], q4 = *(const f32x4*)&qs[s][64 * dh + d];
                    C[d] = f * C[d] + av * k4.x; C[d + 1] = f * C[d + 1] + av * k4.y; C[d + 2] = f * C[d + 2] + av * k4.z; C[d + 3] = f * C[d + 3] + av * k4.w;
                    num += C[d] * q4.x + C[d + 1] * q4.y + C[d + 2] * q4.z + C[d + 3] * q4.w; }
                if (tid < 256) s_num[dh][s][ce] = num; else s_den[tid - 256][s] = num; }
        }
        __syncthreads();
        if (wave < 2) {
#pragma unroll 1
            for (int s = wave; s < 16; s += 2) { const float dn = fmaxf(fabsf(s_den[0][s] + s_den[1][s]), s_em[s]);
                const float h0 = (s_num[0][s][lane] + s_num[1][s][lane]) / dn, h1 = (s_num[0][s][lane + 64] + s_num[1][s][lane + 64]) / dn;
                const float ms = wave_sum(h0 * h0 + h1 * h1) * (1.f / 128.f); const float r = 1.f / sqrtf(ms + EPS); const size_t row = row0 + t0 + s;
#pragma unroll
                for (int p = 0; p < 2; ++p) { const int e = lane + 64 * p; const float hh = p ? h1 : h0;
                    const float o = bf2f(U[row * NU + UOM + h * 128 + e]), z = bf2f(U[row * NU + UZM + h * 128 + e]);
                    Y[row * DM + YM + h * 128 + e] = (bf16)f2bf(sigmoidf_(o) * (hh * r * g_head[h * 128 + e]) * siluf_(z)); } }
        }
        __syncthreads();
    }
}

__device__ __forceinline__ void sb_naive_wave(int wu, const bf16* __restrict__ U, const float* __restrict__ g_head, bf16* __restrict__ Y, int lane) {
    const int tb = wu & 31, h = (wu >> 5) & 3, b = wu >> 7, t = tb * 64 + lane;
    const size_t row0 = (size_t)b * SEQ;
    float q[64], acc[64];
    { const v4u* qp = (const v4u*)(U + (row0 + t) * NU + UQS + h * 64);
#pragma unroll
      for (int i = 0; i < 8; ++i) { const v4u w = qp[i]; q[8 * i] = bflo(w.x) * 0.125f; q[8 * i + 1] = bfhi(w.x) * 0.125f; q[8 * i + 2] = bflo(w.y) * 0.125f; q[8 * i + 3] = bfhi(w.y) * 0.125f;
          q[8 * i + 4] = bflo(w.z) * 0.125f; q[8 * i + 5] = bfhi(w.z) * 0.125f; q[8 * i + 6] = bflo(w.w) * 0.125f; q[8 * i + 7] = bfhi(w.w) * 0.125f; } }
#pragma unroll
    for (int d = 0; d < 64; ++d) acc[d] = 0.f;
    float suffix = 0.f;
    for (int s = tb * 64 + 62; s >= 0; --s) {
        const v4u* kp = (const v4u*)(U + (row0 + s) * NU + UKS + h * 64); const v4u* vp = (const v4u*)(U + (row0 + s) * NU + UVS + h * 64);
        float z = 0.f;
#pragma unroll
        for (int i = 0; i < 8; ++i) { const v4u w = kp[i]; z += q[8 * i] * bflo(w.x) + q[8 * i + 1] * bfhi(w.x) + q[8 * i + 2] * bflo(w.y) + q[8 * i + 3] * bfhi(w.y)
                                                         + q[8 * i + 4] * bflo(w.z) + q[8 * i + 5] * bfhi(w.z) + q[8 * i + 6] * bflo(w.w) + q[8 * i + 7] * bfhi(w.w); }
        if (s < t) {
            const float sp = fmaxf(z, 0.f) + log1pf(expf(-fabsf(z)));
            const float a = expf(z - sp - suffix); suffix += sp;
#pragma unroll
            for (int i = 0; i < 8; ++i) { const v4u w = vp[i]; acc[8 * i] += a * bflo(w.x); acc[8 * i + 1] += a * bfhi(w.x); acc[8 * i + 2] += a * bflo(w.y); acc[8 * i + 3] += a * bfhi(w.y);
                acc[8 * i + 4] += a * bflo(w.z); acc[8 * i + 5] += a * bfhi(w.z); acc[8 * i + 6] += a * bflo(w.w); acc[8 * i + 7] += a * bfhi(w.w); }
        }
    }
    float ss = 0.f;
#pragma unroll
    for (int d = 0; d < 64; ++d) ss += acc[d] * acc[d];
    const float r = 1.f / sqrtf(ss * (1.f / 64.f) + EPS);
    const bf16* zp = U + (row0 + t) * NU + UZS + h * 64; bf16* yp = Y + (row0 + t) * DM + YS + h * 64;
#pragma unroll
    for (int d = 0; d < 64; ++d) yp[d] = (bf16)f2bf(acc[d] * r * g_head[h * 64 + d] * siluf_(bf2f(zp[d])));
}

__device__ __forceinline__ void mem_naive_wave(int wu, const bf16* __restrict__ U, const bf16* __restrict__ KVM, const float* __restrict__ g_head, bf16* __restrict__ Y, int lane) {
    const int tb = wu & 31, h = (wu >> 5) & 3, b = wu >> 7, t = tb * 64 + lane;
    const size_t row0 = (size_t)b * SEQ;
    float q[64], acc[64];
    { const v4u* qp = (const v4u*)(U + (row0 + t) * NU + UQC + h * 64);
#pragma unroll
      for (int i = 0; i < 8; ++i) { const v4u w = qp[i]; q[8 * i] = bflo(w.x) * 0.125f; q[8 * i + 1] = bfhi(w.x) * 0.125f; q[8 * i + 2] = bflo(w.y) * 0.125f; q[8 * i + 3] = bfhi(w.y) * 0.125f;
          q[8 * i + 4] = bflo(w.z) * 0.125f; q[8 * i + 5] = bfhi(w.z) * 0.125f; q[8 * i + 6] = bflo(w.w) * 0.125f; q[8 * i + 7] = bfhi(w.w) * 0.125f; } }
#pragma unroll
    for (int d = 0; d < 64; ++d) acc[d] = 0.f;
    float mrun = -1e30f, l = 0.f;
    for (int j = 0; j < NMEM; ++j) {
        const v4u* kp = (const v4u*)(KVM + (size_t)(b * NMEM + j) * 512 + h * 64); const v4u* vp = (const v4u*)(KVM + (size_t)(b * NMEM + j) * 512 + 256 + h * 64);
        float z = 0.f;
#pragma unroll
        for (int i = 0; i < 8; ++i) { const v4u w = kp[i]; z += q[8 * i] * bflo(w.x) + q[8 * i + 1] * bfhi(w.x) + q[8 * i + 2] * bflo(w.y) + q[8 * i + 3] * bfhi(w.y)
                                                         + q[8 * i + 4] * bflo(w.z) + q[8 * i + 5] * bfhi(w.z) + q[8 * i + 6] * bflo(w.w) + q[8 * i + 7] * bfhi(w.w); }
        const float mn = fmaxf(mrun, z), corr = expf(mrun - mn), p = expf(z - mn); mrun = mn; l = l * corr + p;
#pragma unroll
        for (int i = 0; i < 8; ++i) { const v4u w = vp[i]; acc[8 * i] = acc[8 * i] * corr + p * bflo(w.x); acc[8 * i + 1] = acc[8 * i + 1] * corr + p * bfhi(w.x);
            acc[8 * i + 2] = acc[8 * i + 2] * corr + p * bflo(w.y); acc[8 * i + 3] = acc[8 * i + 3] * corr + p * bfhi(w.y);
            acc[8 * i + 4] = acc[8 * i + 4] * corr + p * bflo(w.z); acc[8 * i + 5] = acc[8 * i + 5] * corr + p * bfhi(w.z);
            acc[8 * i + 6] = acc[8 * i + 6] * corr + p * bflo(w.w); acc[8 * i + 7] = acc[8 * i + 7] * corr + p * bfhi(w.w); }
    }
    const float il = 1.f / l; float ss = 0.f;
#pragma unroll
    for (int d = 0; d < 64; ++d) { acc[d] *= il; ss += acc[d] * acc[d]; }
    const float r = 1.f / sqrtf(ss * (1.f / 64.f) + EPS);
    const bf16* zp = U + (row0 + t) * NU + UZC + h * 64; bf16* yp = Y + (row0 + t) * DM + YC + h * 64;
#pragma unroll
    for (int d = 0; d < 64; ++d) yp[d] = (bf16)f2bf(acc[d] * r * g_head[h * 64 + d] * siluf_(bf2f(zp[d])));
}

__device__ __forceinline__ void final_rows(const float* __restrict__ x, const float* __restrict__ g_post, float* out, int gw, int NGW, int lane) {
    for (int m = gw; m < M; m += NGW) {
        const f32x4* zr = (const f32x4*)(out + (size_t)m * DM) + lane; const f32x4* xr = (const f32x4*)(x + (size_t)m * DM) + lane; const f32x4* gr = (const f32x4*)g_post + lane;
        f32x4 v[4]; float s = 0.f;
#pragma unroll
        for (int j = 0; j < 4; ++j) { v[j] = zr[64 * j]; s += (v[j].x * v[j].x + v[j].y * v[j].y) + (v[j].z * v[j].z + v[j].w * v[j].w); }
        const float rstd = 1.f / sqrtf(wave_sum(s) * (1.f / DM) + EPS);
        f32x4* orow = (f32x4*)(out + (size_t)m * DM) + lane;
#pragma unroll
        for (int j = 0; j < 4; ++j) orow[64 * j] = xr[64 * j] + v[j] * rstd * gr[64 * j];
    }
}

namespace mx {
typedef short bf16x8 __attribute__((ext_vector_type(8)));
typedef short s16x4 __attribute__((ext_vector_type(4)));
typedef float f32x16 __attribute__((ext_vector_type(16)));
typedef unsigned u32x4 __attribute__((ext_vector_type(4)));
typedef LAS unsigned char* ldsp;
#define MFMA32(a, b, c) __builtin_amdgcn_mfma_f32_32x32x16_bf16((a), (b), (c), 0, 0, 0)
__device__ __forceinline__ int crow(int r, int hi) { return (r & 3) + 8 * (r >> 2) + 4 * hi; }
__device__ __forceinline__ s16x4 vtr(ldsp p) { return __builtin_bit_cast(s16x4, __builtin_amdgcn_ds_read_tr16_b64_v4i16((LAS s16x4*)p)); }
__device__ __forceinline__ bf16x8 cat8(s16x4 lo, s16x4 hi) { return __builtin_shufflevector(lo, hi, 0, 1, 2, 3, 4, 5, 6, 7); }
__device__ __forceinline__ unsigned cvtpk(float lo, float hi) { typedef float f2 __attribute__((ext_vector_type(2))); typedef __bf16 b2 __attribute__((ext_vector_type(2))); f2 v = {lo, hi}; b2 b = __builtin_convertvector(v, b2); return __builtin_bit_cast(unsigned, b); }
__device__ __forceinline__ bf16x8 pack8(const f32x16& p, int s) {
    u32x4 w; w.x = cvtpk(p[8 * s], p[8 * s + 1]); w.y = cvtpk(p[8 * s + 2], p[8 * s + 3]); w.z = cvtpk(p[8 * s + 4], p[8 * s + 5]); w.w = cvtpk(p[8 * s + 6], p[8 * s + 7]); return __builtin_bit_cast(bf16x8, w); }
constexpr float LOG2E = 1.4426950408889634f;

__device__ __forceinline__ void stage_kv(const bf16* kbase, const bf16* vbase, size_t pitch, ldsp kslot, ldsp vslot, int wid, int lane) {
    const u32x4 kx = *(const u32x4*)(kbase + (size_t)lane * pitch + wid * 8);
    const u32x4 vx = *(const u32x4*)(vbase + (size_t)(16 * (wid & 3) + (lane >> 2)) * pitch + (wid >> 2) * 32 + (lane & 3) * 8);
    *(LAS u32x4*)(kslot + wid * 1024 + lane * 16) = kx;
    *(LAS u32x4*)(vslot + wid * 1024 + lane * 16) = vx;
}
__device__ __forceinline__ void qkt(f32x16& p0, f32x16& p1, ldsp kslot, const bf16x8 (&qr)[4], int r32, int hi) {
    const ldsp kb = kslot + hi * 1024 + r32 * 16;
    f32x16 z;
#pragma unroll
    for (int i = 0; i < 16; ++i) z[i] = 0.f;
    p0 = z; p1 = z;
#pragma unroll
    for (int d0 = 0; d0 < 4; ++d0) { const bf16x8 b0 = *(const LAS bf16x8*)(kb + d0 * 2048), b1 = *(const LAS bf16x8*)(kb + d0 * 2048 + 512);
        p0 = MFMA32(b0, qr[d0], p0); p1 = MFMA32(b1, qr[d0], p1); }
}
__device__ __forceinline__ void qkt_half(f32x16& p, ldsp kslot, const bf16x8 (&qr)[4], int half, int r32, int hi) {
    const ldsp kb = kslot + hi * 1024 + r32 * 16 + half * 512;
#pragma unroll
    for (int i = 0; i < 16; ++i) p[i] = 0.f;
#pragma unroll
    for (int d0 = 0; d0 < 4; ++d0) { const bf16x8 b0 = *(const LAS bf16x8*)(kb + d0 * 2048); p = MFMA32(b0, qr[d0], p); }
}
__device__ __forceinline__ void pv64(f32x16 (&o)[2], ldsp vslot, const bf16x8 (&pa)[4], int lane, int hi) {
    const ldsp vb = vslot + ((lane >> 4) & 1) * 32 + (lane & 3) * 8 + (4 * hi + ((lane & 15) >> 2)) * 64;
#pragma unroll
    for (int d0 = 0; d0 < 2; ++d0)
#pragma unroll
        for (int ks = 0; ks < 4; ++ks) { const s16x4 lo = vtr(vb + d0 * 4096 + ks * 1024), h4 = vtr(vb + d0 * 4096 + ks * 1024 + 512); o[d0] = MFMA32(pa[ks], cat8(lo, h4), o[d0]); }
}
template <bool MASK> __device__ __forceinline__ float sb_half(f32x16& y, float base, int s0, int t, int hi) {
    float sp[16];
#pragma unroll
    for (int r = 0; r < 16; ++r) { const float v = y[r]; float s = fmaxf(v, 0.f) + __builtin_amdgcn_logf(1.f + __builtin_amdgcn_exp2f(-fabsf(v)));
        if (MASK) { if (!(s0 + crow(r, hi) < t)) s = 0.f; } sp[r] = s; }
    float bs[4], ot[4];
#pragma unroll
    for (int g = 0; g < 4; ++g) { bs[g] = (sp[4 * g] + sp[4 * g + 1]) + (sp[4 * g + 2] + sp[4 * g + 3]); ot[g] = __shfl_xor(bs[g], 32); }
    float so[4]; so[3] = 0.f; so[2] = bs[3] + ot[3]; so[1] = so[2] + (bs[2] + ot[2]); so[0] = so[1] + (bs[1] + ot[1]);
    const float total = so[0] + (bs[0] + ot[0]);
#pragma unroll
    for (int g = 0; g < 4; ++g) { const float e = base + so[g] + (hi == 0 ? ot[g] : 0.f);
        const float c3 = e + sp[4 * g + 3], c2 = c3 + sp[4 * g + 2], c1 = c2 + sp[4 * g + 1], c0 = c1 + sp[4 * g];
        float a0 = __builtin_amdgcn_exp2f(y[4 * g] - c0), a1 = __builtin_amdgcn_exp2f(y[4 * g + 1] - c1), a2 = __builtin_amdgcn_exp2f(y[4 * g + 2] - c2), a3 = __builtin_amdgcn_exp2f(y[4 * g + 3] - c3);
        if (MASK) { if (!(s0 + crow(4 * g, hi) < t)) a0 = 0.f; if (!(s0 + crow(4 * g + 1, hi) < t)) a1 = 0.f; if (!(s0 + crow(4 * g + 2, hi) < t)) a2 = 0.f; if (!(s0 + crow(4 * g + 3, hi) < t)) a3 = 0.f; }
        y[4 * g] = a0; y[4 * g + 1] = a1; y[4 * g + 2] = a2; y[4 * g + 3] = a3; }
    return total;
}
constexpr int ATT_K = 0, ATT_V = 32768, ATT_STG = 65536, ATT_STG_W = 8320, ATT_FLAG = ATT_STG + 8 * ATT_STG_W;
constexpr float SB_THR = 127.f;

__device__ __forceinline__ void attn_epilogue(const f32x16 (&o)[2], LAS float* stg, float rs, const float* __restrict__ gain, const bf16* __restrict__ zrow, bf16* __restrict__ yrow, int r32, int hi) {
#pragma unroll
    for (int d0 = 0; d0 < 2; ++d0)
#pragma unroll
        for (int r = 0; r < 16; ++r) stg[crow(r, hi) * 65 + d0 * 32 + r32] = o[d0][r];
    __builtin_amdgcn_s_waitcnt(0xC07F); asm volatile("" ::: "memory");
    float v[32]; float ss = 0.f;
#pragma unroll
    for (int i = 0; i < 32; ++i) { v[i] = stg[r32 * 65 + hi * 32 + i] * rs; ss += v[i] * v[i]; }
    ss += __shfl_xor(ss, 32);
    const float rn = 1.f / sqrtf(ss * (1.f / 64.f) + EPS);
#pragma unroll
    for (int c = 0; c < 4; ++c) { const u32x4 zw = *(const u32x4*)(zrow + hi * 32 + c * 8); const f32x4 g0 = *(const f32x4*)(gain + hi * 32 + c * 8), g1 = *(const f32x4*)(gain + hi * 32 + c * 8 + 4);
        u32x4 ow;
        ow.x = cvtpk(v[8 * c] * rn * g0.x * siluf_(bflo(zw.x)), v[8 * c + 1] * rn * g0.y * siluf_(bfhi(zw.x)));
        ow.y = cvtpk(v[8 * c + 2] * rn * g0.z * siluf_(bflo(zw.y)), v[8 * c + 3] * rn * g0.w * siluf_(bfhi(zw.y)));
        ow.z = cvtpk(v[8 * c + 4] * rn * g1.x * siluf_(bflo(zw.z)), v[8 * c + 5] * rn * g1.y * siluf_(bfhi(zw.z)));
        ow.w = cvtpk(v[8 * c + 6] * rn * g1.z * siluf_(bflo(zw.w)), v[8 * c + 7] * rn * g1.w * siluf_(bfhi(zw.w)));
        *(u32x4*)(yrow + hi * 32 + c * 8) = ow; }
}

__device__ __forceinline__ void sb_unit(int b, int h, int qb, const bf16* __restrict__ U, const float* __restrict__ g_head, bf16* __restrict__ Y, ldsp lds) {
    const int tid = threadIdx.x, lane = tid & 63, r32 = lane & 31, hi = lane >> 5, wid = __builtin_amdgcn_readfirstlane(tid >> 6);
    const size_t row0 = (size_t)b * SEQ; const int q0 = qb * 256, qw = q0 + 32 * wid, t = qw + r32;
    LAS unsigned* flag = (LAS unsigned*)(lds + ATT_FLAG);
    const bf16* Kg = U + row0 * NU + UKS + h * 64; const bf16* Vg = U + row0 * NU + UVS + h * 64;
    bf16x8 qr[4];
#pragma unroll
    for (int d0 = 0; d0 < 4; ++d0) qr[d0] = *(const bf16x8*)(U + (row0 + t) * NU + UQS + h * 64 + d0 * 16 + hi * 8);
    f32x16 o[2];
#pragma unroll
    for (int i = 0; i < 16; ++i) { o[0][i] = 0.f; o[1][i] = 0.f; }
    float R = 0.f; bool done = false;
    const int my_jt = qw >> 6;
    if (tid < 8) flag[tid] = 0u;
#pragma unroll 1
    for (int jt = 4 * qb + 3; jt >= 0; --jt) {
        __syncthreads();
        { unsigned all = 1u;
#pragma unroll
          for (int i = 0; i < 8; ++i) all &= flag[i];
          if (all) break; }
        stage_kv(Kg + (size_t)jt * 64 * NU, Vg + (size_t)jt * 64 * NU, NU, lds + ATT_K, lds + ATT_V, wid, lane);
        __syncthreads();
        if (jt <= my_jt && !done) {
            bf16x8 pa[4]; f32x16 p; float t1, t0;
            qkt_half(p, lds + ATT_K, qr, 1, r32, hi);
#pragma unroll
            for (int i = 0; i < 16; ++i) p[i] *= 0.125f * LOG2E;
            if (jt == my_jt) t1 = sb_half<true>(p, R, jt * 64 + 32, t, hi); else t1 = sb_half<false>(p, R, jt * 64 + 32, t, hi);
            pa[2] = pack8(p, 0); pa[3] = pack8(p, 1);
            qkt_half(p, lds + ATT_K, qr, 0, r32, hi);
#pragma unroll
            for (int i = 0; i < 16; ++i) p[i] *= 0.125f * LOG2E;
            if (jt == my_jt) t0 = sb_half<true>(p, R + t1, jt * 64, t, hi); else t0 = sb_half<false>(p, R + t1, jt * 64, t, hi);
            pa[0] = pack8(p, 0); pa[1] = pack8(p, 1);
            R += t1 + t0;
            pv64(o, lds + ATT_V, pa, lane, hi);
            done = __all(R >= SB_THR) != 0;
        }
        if (lane == 0 && done) flag[wid] = 1u;
    }
    attn_epilogue(o, (LAS float*)(lds + ATT_STG + wid * ATT_STG_W), 1.f, g_head + h * 64, U + (row0 + t) * NU + UZS + h * 64, Y + (row0 + t) * DM + YS + h * 64, r32, hi);
    __syncthreads();
}

__device__ __forceinline__ void mem_unit(int b, int h, int qb, const bf16* __restrict__ U, const bf16* __restrict__ KVM, const float* __restrict__ g_head, bf16* __restrict__ Y, ldsp lds) {
    const int tid = threadIdx.x, lane = tid & 63, r32 = lane & 31, hi = lane >> 5, wid = __builtin_amdgcn_readfirstlane(tid >> 6);
    const size_t row0 = (size_t)b * SEQ; const int t = qb * 256 + 32 * wid + r32;
    const bf16* Kg = KVM + (size_t)b * NMEM * 512 + h * 64; const bf16* Vg = Kg + 256;
#pragma unroll
    for (int jt = 0; jt < 4; ++jt) stage_kv(Kg + (size_t)jt * 64 * 512, Vg + (size_t)jt * 64 * 512, 512, lds + ATT_K + jt * 8192, lds + ATT_V + jt * 8192, wid, lane);
    bf16x8 qr[4];
#pragma unroll
    for (int d0 = 0; d0 < 4; ++d0) qr[d0] = *(const bf16x8*)(U + (row0 + t) * NU + UQC + h * 64 + d0 * 16 + hi * 8);
    __syncthreads();
    float mx_ = -3.0e38f;
#pragma unroll 1
    for (int jt = 0; jt < 4; ++jt) { f32x16 p0, p1; qkt(p0, p1, lds + ATT_K + jt * 8192, qr, r32, hi);
#pragma unroll
        for (int i = 0; i < 16; ++i) mx_ = fmaxf(mx_, fmaxf(p0[i], p1[i])); }
    mx_ = fmaxf(mx_, __shfl_xor(mx_, 32));
    const float mc = mx_ * (0.125f * LOG2E);
    f32x16 o[2];
#pragma unroll
    for (int i = 0; i < 16; ++i) { o[0][i] = 0.f; o[1][i] = 0.f; }
    float l = 0.f;
#pragma unroll 1
    for (int jt = 0; jt < 4; ++jt) { f32x16 p0, p1; qkt(p0, p1, lds + ATT_K + jt * 8192, qr, r32, hi);
#pragma unroll
        for (int i = 0; i < 16; ++i) { p0[i] = __builtin_amdgcn_exp2f(p0[i] * (0.125f * LOG2E) - mc); p1[i] = __builtin_amdgcn_exp2f(p1[i] * (0.125f * LOG2E) - mc); l += p0[i] + p1[i]; }
        bf16x8 pa[4]; pa[0] = pack8(p0, 0); pa[1] = pack8(p0, 1); pa[2] = pack8(p1, 0); pa[3] = pack8(p1, 1);
        pv64(o, lds + ATT_V + jt * 8192, pa, lane, hi); }
    l += __shfl_xor(l, 32);
    attn_epilogue(o, (LAS float*)(lds + ATT_STG + wid * ATT_STG_W), 1.f / l, g_head + h * 64, U + (row0 + t) * NU + UZC + h * 64, Y + (row0 + t) * DM + YC + h * 64, r32, hi);
    __syncthreads();
}
}

namespace ml {
using namespace mx;
constexpr int QK_CS = 1040;
constexpr int V_BS = 4160;
constexpr int ML_Q = 0, ML_K = 16640, ML_V = 33280, ML_VW = 49920, ML_CT = 66560, ML_H = 99328, H_LD = 132, ML_TAB = ML_H + 64 * H_LD * 4;
constexpr int T_A2 = 0, T_N = 64, T_CW = 192, T_SCR = T_CW + 1280, T_NS = T_SCR + 512, T_END = T_NS + 1024;
static_assert(ML_TAB + T_END * 4 <= 147456 - 64, "mLSTM LDS map");

__device__ __forceinline__ void mlstm_unit(int b, int h, const bf16* __restrict__ U, const float* __restrict__ G, const float* __restrict__ conv_w, const float* __restrict__ conv_b,
                                           const float* __restrict__ g_head, bf16* __restrict__ Y, ldsp lds) {
    const int tid = threadIdx.x, lane = tid & 63, r32 = lane & 31, hi = lane >> 5, wid = __builtin_amdgcn_readfirstlane(tid >> 6);
    const size_t row0 = (size_t)b * SEQ;
    LAS float* tab = (LAS float*)(lds + ML_TAB);
    LAS float* Hst = (LAS float*)(lds + ML_H);
    for (int i = tid; i < 2048; i += 512) *(LAS u32x4*)(lds + ML_CT + i * 16) = (u32x4){0u, 0u, 0u, 0u};
    if (tid < 128) tab[T_N + tid] = 0.f;
    for (int i = tid; i < 1280; i += 512) { float v;
        if (i < 512) v = conv_w[(i >> 7) * 1024 + h * 128 + (i & 127)];
        else if (i < 1024) v = conv_w[((i - 512) >> 7) * 1024 + 512 + h * 128 + (i & 127)];
        else if (i < 1152) v = conv_b[h * 128 + (i & 127)]; else v = conv_b[512 + h * 128 + (i & 127)];
        tab[T_CW + i] = v; }
    f32x16 Cacc[2];
#pragma unroll
    for (int i = 0; i < 16; ++i) { Cacc[0][i] = 0.f; Cacc[1][i] = 0.f; }
    float m_prev = 0.f;
    const int qblk = wid & 1, eq = wid >> 1, dblk = wid & 3, epair = wid >> 2;
    const int ch = tid & 15, rg = tid >> 4;
    __syncthreads();
#pragma unroll 1
    for (int c = 0; c < SEQ / 64; ++c) {
        const int t0 = c * 64;
        float bcum, a_, Mt, wend, iw, em, decay, m_new;
        { const float lf = G[(row0 + t0 + lane) * 8 + 4 + h], ip = G[(row0 + t0 + lane) * 8 + h];
          bcum = lf;
#pragma unroll
          for (int off = 1; off < 64; off <<= 1) { const float y = __shfl_up(bcum, off); if (lane >= off) bcum += y; }
          a_ = ip - bcum; float pm = a_;
#pragma unroll
          for (int off = 1; off < 64; off <<= 1) { const float y = __shfl_up(pm, off); if (lane >= off) pm = fmaxf(pm, y); }
          Mt = fmaxf(m_prev, pm); const float Mlast = __shfl(Mt, 63), blast = __shfl(bcum, 63);
          wend = expf(a_ - Mlast); iw = expf(m_prev - Mt); em = expf(-bcum - Mt); decay = expf(m_prev - Mlast); m_new = blast + Mlast;
          if (wid == 0) tab[T_A2 + lane] = a_ * LOG2E; }
        { const int rA = 2 * rg;
          const size_t gbase = (row0 + t0 + rA) * (size_t)NU + h * 128 + 8 * ch;
#pragma unroll
          for (int which = 0; which < 2; ++which) {
              const bf16* src = U + gbase + (which ? UKM : UQM);
              float x[5][8];
#pragma unroll
              for (int i = 0; i < 5; ++i) { const int trel = t0 + rA - 3 + i;
                  u32x4 w = (u32x4){0u, 0u, 0u, 0u}; if (trel >= 0) w = *(const u32x4*)(src + (ptrdiff_t)(i - 3) * NU);
                  x[i][0] = bflo(w.x); x[i][1] = bfhi(w.x); x[i][2] = bflo(w.y); x[i][3] = bfhi(w.y); x[i][4] = bflo(w.z); x[i][5] = bfhi(w.z); x[i][6] = bflo(w.w); x[i][7] = bfhi(w.w); }
              const LAS float* cw = tab + T_CW + which * 512 + 8 * ch; const LAS float* cb = tab + T_CW + 1024 + which * 128 + 8 * ch;
              float o0[8], o1[8];
#pragma unroll
              for (int d = 0; d < 8; ++d) { o0[d] = cb[d]; o1[d] = cb[d]; }
#pragma unroll
              for (int j = 0; j < 4; ++j)
#pragma unroll
                  for (int d = 0; d < 8; ++d) { const float wj = cw[j * 128 + d]; o0[d] += wj * x[j][d]; o1[d] += wj * x[j + 1][d]; }
              const float sc = which ? 0.08838834764831845f : 1.f;
#pragma unroll
              for (int d = 0; d < 8; ++d) { o0[d] = siluf_(o0[d]) * sc; o1[d] = siluf_(o1[d]) * sc; }
              u32x4 w0, w1; w0.x = cvtpk(o0[0], o0[1]); w0.y = cvtpk(o0[2], o0[3]); w0.z = cvtpk(o0[4], o0[5]); w0.w = cvtpk(o0[6], o0[7]);
              w1.x = cvtpk(o1[0], o1[1]); w1.y = cvtpk(o1[2], o1[3]); w1.z = cvtpk(o1[4], o1[5]); w1.w = cvtpk(o1[6], o1[7]);
              const ldsp dst = lds + (which ? ML_K : ML_Q) + ch * QK_CS + rA * 16;
              *(LAS u32x4*)dst = w0; *(LAS u32x4*)(dst + 16) = w1; }
          const float we0 = __shfl(wend, rA), we1 = __shfl(wend, rA + 1);
          const bf16* vsrc = U + gbase + UVM;
          const u32x4 v0 = *(const u32x4*)vsrc, v1 = *(const u32x4*)(vsrc + NU);
          const ldsp vd = lds + ML_V + (ch >> 2) * V_BS + rA * 64 + (ch & 3) * 16; const ldsp vwd = vd + (ML_VW - ML_V);
          *(LAS u32x4*)vd = v0; *(LAS u32x4*)(vd + 64) = v1;
          u32x4 s0, s1;
          s0.x = cvtpk(bflo(v0.x) * we0, bfhi(v0.x) * we0); s0.y = cvtpk(bflo(v0.y) * we0, bfhi(v0.y) * we0); s0.z = cvtpk(bflo(v0.z) * we0, bfhi(v0.z) * we0); s0.w = cvtpk(bflo(v0.w) * we0, bfhi(v0.w) * we0);
          s1.x = cvtpk(bflo(v1.x) * we1, bfhi(v1.x) * we1); s1.y = cvtpk(bflo(v1.y) * we1, bfhi(v1.y) * we1); s1.z = cvtpk(bflo(v1.z) * we1, bfhi(v1.z) * we1); s1.w = cvtpk(bflo(v1.w) * we1, bfhi(v1.w) * we1);
          *(LAS u32x4*)vwd = s0; *(LAS u32x4*)(vwd + 64) = s1; }
        __syncthreads();
        {
            const int tq = 32 * qblk + r32;
            const float M2 = __shfl(Mt, tq) * LOG2E, iw_q = __shfl(iw, tq), em_q = __shfl(em, tq);
            bf16x8 qf[8];
#pragma unroll
            for (int ks = 0; ks < 8; ++ks) qf[ks] = *(const LAS bf16x8*)(lds + ML_Q + (2 * ks + hi) * QK_CS + tq * 16);
            f32x16 osv, oqc;
#pragma unroll
            for (int i = 0; i < 16; ++i) { osv[i] = 0.f; oqc[i] = 0.f; }
            float den = 0.f;
            const ldsp vb = lds + ML_V + eq * V_BS + ((lane >> 4) & 1) * 32 + (lane & 3) * 8 + (4 * hi + ((lane & 15) >> 2)) * 64;
#pragma unroll
            for (int kt = 0; kt < 2; ++kt) {
                if (kt <= qblk) {
                    f32x16 p;
#pragma unroll
                    for (int i = 0; i < 16; ++i) p[i] = 0.f;
#pragma unroll
                    for (int ks = 0; ks < 8; ++ks) { const bf16x8 kf = *(const LAS bf16x8*)(lds + ML_K + (2 * ks + hi) * QK_CS + (32 * kt + r32) * 16); p = MFMA32(kf, qf[ks], p); }
#pragma unroll
                    for (int g = 0; g < 4; ++g) { const f32x4 a4 = *(const LAS f32x4*)(tab + T_A2 + 32 * kt + 8 * g + 4 * hi);
#pragma unroll
                        for (int j = 0; j < 4; ++j) { float w = __builtin_amdgcn_exp2f(a4[j] - M2); if (kt == qblk) { if (8 * g + 4 * hi + j > r32) w = 0.f; }
                            const float v = p[4 * g + j] * w; p[4 * g + j] = v; den += v; } }
                    const bf16x8 pa0 = pack8(p, 0), pa1 = pack8(p, 1);
                    { const s16x4 lo = vtr(vb + (2 * kt) * 1024), h4 = vtr(vb + (2 * kt) * 1024 + 512); osv = MFMA32(pa0, cat8(lo, h4), osv); }
                    { const s16x4 lo = vtr(vb + (2 * kt + 1) * 1024), h4 = vtr(vb + (2 * kt + 1) * 1024 + 512); osv = MFMA32(pa1, cat8(lo, h4), osv); }
                }
            }
            den += __shfl_xor(den, 32);
            float qn = 0.f;
#pragma unroll
            for (int ks = 0; ks < 8; ++ks) { const bf16x8 kf = *(const LAS bf16x8*)(lds + ML_CT + (2 * ks + hi) * 2048 + (32 * eq + r32) * 16); oqc = MFMA32(qf[ks], kf, oqc);
                const f32x4 n0 = *(const LAS f32x4*)(tab + T_N + 16 * ks + 8 * hi), n1 = *(const LAS f32x4*)(tab + T_N + 16 * ks + 8 * hi + 4);
                const u32x4 qw = __builtin_bit_cast(u32x4, qf[ks]);
                qn += bflo(qw.x) * n0.x + bfhi(qw.x) * n0.y + bflo(qw.y) * n0.z + bfhi(qw.y) * n0.w + bflo(qw.z) * n1.x + bfhi(qw.z) * n1.y + bflo(qw.w) * n1.z + bfhi(qw.w) * n1.w; }
            qn += __shfl_xor(qn, 32);
            const float dinv = 1.f / fmaxf(fabsf(den + iw_q * qn), em_q);
            LAS float* scr = tab + T_SCR + wid * 64;
            if (hi == 0) { scr[r32] = iw_q; scr[32 + r32] = dinv; }
            __builtin_amdgcn_s_waitcnt(0xC07F); asm volatile("" ::: "memory");
#pragma unroll
            for (int g = 0; g < 4; ++g) { const f32x4 i4 = *(const LAS f32x4*)(scr + 8 * g + 4 * hi), d4 = *(const LAS f32x4*)(scr + 32 + 8 * g + 4 * hi);
#pragma unroll
                for (int j = 0; j < 4; ++j) Hst[(32 * qblk + 8 * g + 4 * hi + j) * H_LD + 32 * eq + r32] = (osv[4 * g + j] + i4[j] * oqc[4 * g + j]) * d4[j]; }
        }
        {
            const int blk = (lane >> 4) & 1, q4 = (lane & 15) >> 2, p4 = lane & 3;
            const ldsp ka = lds + ML_K + (4 * dblk + 2 * blk + (p4 >> 1)) * QK_CS + (4 * hi + q4) * 16 + (p4 & 1) * 8;
            const ldsp vwb = lds + ML_VW + (2 * epair) * V_BS + blk * 32 + p4 * 8 + (4 * hi + q4) * 64;
#pragma unroll
            for (int i = 0; i < 16; ++i) { Cacc[0][i] *= decay; Cacc[1][i] *= decay; }
#pragma unroll
            for (int ks = 0; ks < 4; ++ks) { const bf16x8 af = cat8(vtr(ka + ks * 256), vtr(ka + ks * 256 + 128));
                const bf16x8 b0 = cat8(vtr(vwb + ks * 1024), vtr(vwb + ks * 1024 + 512)), b1 = cat8(vtr(vwb + V_BS + ks * 1024), vtr(vwb + V_BS + ks * 1024 + 512));
                Cacc[0] = MFMA32(af, b0, Cacc[0]); Cacc[1] = MFMA32(af, b1, Cacc[1]); }
            const float we0 = __shfl(wend, 2 * rg), we1 = __shfl(wend, 2 * rg + 1);
            const u32x4 k0 = *(const LAS u32x4*)(lds + ML_K + ch * QK_CS + (2 * rg) * 16), k1 = *(const LAS u32x4*)(lds + ML_K + ch * QK_CS + (2 * rg + 1) * 16);
            float np_[8];
            np_[0] = bflo(k0.x) * we0 + bflo(k1.x) * we1; np_[1] = bfhi(k0.x) * we0 + bfhi(k1.x) * we1; np_[2] = bflo(k0.y) * we0 + bflo(k1.y) * we1; np_[3] = bfhi(k0.y) * we0 + bfhi(k1.y) * we1;
            np_[4] = bflo(k0.z) * we0 + bflo(k1.z) * we1; np_[5] = bfhi(k0.z) * we0 + bfhi(k1.z) * we1; np_[6] = bflo(k0.w) * we0 + bflo(k1.w) * we1; np_[7] = bfhi(k0.w) * we0 + bfhi(k1.w) * we1;
#pragma unroll
            for (int d = 0; d < 8; ++d) { np_[d] += __shfl_xor(np_[d], 16); np_[d] += __shfl_xor(np_[d], 32); }
            if (lane < 16) {
#pragma unroll
                for (int d = 0; d < 8; ++d) tab[T_NS + wid * 128 + 8 * lane + d] = np_[d]; }
        }
        __syncthreads();
        {
#pragma unroll
            for (int i = 0; i < 2; ++i)
#pragma unroll
                for (int g = 0; g < 4; ++g) { typedef unsigned u32x2 __attribute__((ext_vector_type(2))); u32x2 w; w.x = cvtpk(Cacc[i][4 * g], Cacc[i][4 * g + 1]); w.y = cvtpk(Cacc[i][4 * g + 2], Cacc[i][4 * g + 3]);
                    *(LAS u32x2*)(lds + ML_CT + (4 * dblk + g) * 2048 + (32 * (2 * epair + i) + r32) * 16 + 8 * hi) = w; }
            if (tid < 128) { float s = decay * tab[T_N + tid];
#pragma unroll
                for (int w = 0; w < 8; ++w) s += tab[T_NS + w * 128 + tid];
                tab[T_N + tid] = s; }
            const int t = tid >> 3, e0 = 16 * (tid & 7);
            float hv[16]; float ss = 0.f;
#pragma unroll
            for (int i = 0; i < 4; ++i) { const f32x4 x = *(const LAS f32x4*)(Hst + t * H_LD + e0 + 4 * i); hv[4 * i] = x.x; hv[4 * i + 1] = x.y; hv[4 * i + 2] = x.z; hv[4 * i + 3] = x.w; ss += (x.x * x.x + x.y * x.y) + (x.z * x.z + x.w * x.w); }
            ss += __shfl_xor(ss, 1); ss += __shfl_xor(ss, 2); ss += __shfl_xor(ss, 4);
            const float rn = 1.f / sqrtf(ss * (1.f / 128.f) + EPS);
            const size_t row = row0 + t0 + t;
            const bf16* op = U + row * NU + UOM + h * 128 + e0; const bf16* zp = U + row * NU + UZM + h * 128 + e0; const float* gp = g_head + h * 128 + e0;
            bf16* yp = Y + row * DM + YM + h * 128 + e0;
#pragma unroll
            for (int c2 = 0; c2 < 2; ++c2) { const u32x4 ow = *(const u32x4*)(op + 8 * c2), zw = *(const u32x4*)(zp + 8 * c2); const f32x4 g0 = *(const f32x4*)(gp + 8 * c2), g1 = *(const f32x4*)(gp + 8 * c2 + 4);
                u32x4 yw;
                yw.x = cvtpk(sigmoidf_(bflo(ow.x)) * hv[8 * c2] * rn * g0.x * siluf_(bflo(zw.x)), sigmoidf_(bfhi(ow.x)) * hv[8 * c2 + 1] * rn * g0.y * siluf_(bfhi(zw.x)));
                yw.y = cvtpk(sigmoidf_(bflo(ow.y)) * hv[8 * c2 + 2] * rn * g0.z * siluf_(bflo(zw.y)), sigmoidf_(bfhi(ow.y)) * hv[8 * c2 + 3] * rn * g0.w * siluf_(bfhi(zw.y)));
                yw.z = cvtpk(sigmoidf_(bflo(ow.z)) * hv[8 * c2 + 4] * rn * g1.x * siluf_(bflo(zw.z)), sigmoidf_(bfhi(ow.z)) * hv[8 * c2 + 5] * rn * g1.y * siluf_(bfhi(zw.z)));
                yw.w = cvtpk(sigmoidf_(bflo(ow.w)) * hv[8 * c2 + 6] * rn * g1.z * siluf_(bflo(zw.w)), sigmoidf_(bfhi(ow.w)) * hv[8 * c2 + 7] * rn * g1.w * siluf_(bfhi(zw.w)));
                *(u32x4*)(yp + 8 * c2) = yw; }
        }
        m_prev = m_new;
    }
    __syncthreads();
}
}

#ifndef USE_MFMA_MLSTM
#define USE_MFMA_MLSTM 1
#endif

#ifndef USE_MFMA_SB
#define USE_MFMA_SB 1
#endif
#ifndef USE_MFMA_MEM
#define USE_MFMA_MEM 1
#endif

constexpr int LDS_BYTES = 147456;
struct Args {
    const float *x, *mem, *g_pre, *w_in, *conv_w, *conv_b, *i_bias, *f_bias, *g_mh, *g_sh, *g_ch, *g_mem, *w_kv, *w_out, *g_post;
    float* out; unsigned char* ws;
};

__global__ void __launch_bounds__(512, 2) hybrid_fwd(Args a) {
    extern __shared__ __attribute__((aligned(16))) unsigned char lds[];
    cg::grid_group grid = cg::this_grid();
    const int tid = threadIdx.x, lane = tid & 63, wave = __builtin_amdgcn_readfirstlane(tid >> 6);
    const int nb = (int)gridDim.x, bx = (int)blockIdx.x;
    unsigned char* ws = a.ws;
    bf16* WIN = (bf16*)(ws + WS_WIN); bf16* WO = (bf16*)(ws + WS_WO); bf16* WKV = (bf16*)(ws + WS_WKV); float* G = (float*)(ws + WS_G);
    bf16* MEMN = (bf16*)(ws + WS_MEMN); bf16* KVM = (bf16*)(ws + WS_KVM); bf16* XN = (bf16*)(ws + WS_XN); bf16* Y = (bf16*)(ws + WS_Y); bf16* U = (bf16*)(ws + WS_U);

    { ProArgs pa{a.x, a.mem, a.g_pre, a.w_in, a.i_bias, a.f_bias, a.g_mem, a.w_kv, a.w_out, WIN, WO, WKV, XN, MEMN, G};
      phase_prologue(pa, (float*)lds, nb, bx); }
    grid.sync();

    { pg8::Gemm g{XN, WIN, M, NU, DM}; pg8::StaticOrder S; S.init(M, NU, nb, bx);
      pg8::EpiBf16<0> E{U, NU, nullptr, 0, 0, 1.f};
      pg8::gemm_phase<pg8::EpiBf16<0>, pg8::StaticOrder, true, true>((PG8_LAS unsigned char*)lds, g, S, E); }
    { pg8::Gemm g{MEMN, WKV, MMEM, 512, DM}; pg8::StaticOrder S; S.init(MMEM, 512, nb, bx);
      pg8::EpiBf16<0> E{KVM, 512, nullptr, 0, 0, 1.f};
      pg8::gemm_phase<pg8::EpiBf16<0>, pg8::StaticOrder, true, true>((PG8_LAS unsigned char*)lds, g, S, E); }
    grid.sync();

    {
#if USE_MFMA_MLSTM
        for (int u = bx; u < 128; u += nb) ml::mlstm_unit(u >> 2, u & 3, U, G, a.conv_w, a.conv_b, a.g_mh, Y, (mx::ldsp)lds);
#else
        for (int u = bx; u < 128; u += nb) mlstm_naive_unit(u >> 2, u & 3, U, G, a.conv_w, a.conv_b, a.g_mh, Y, (float*)lds);
#endif
#if USE_MFMA_SB
        for (int u = bx; u < 1024; u += nb) mx::sb_unit((u & 127) >> 2, u & 3, u >> 7, U, a.g_sh, Y, (mx::ldsp)lds);
#else
        for (int wu = bx * 8 + wave; wu < 4096; wu += nb * 8) sb_naive_wave(wu, U, a.g_sh, Y, lane);
#endif
#if USE_MFMA_MEM
        for (int u = bx; u < 1024; u += nb) mx::mem_unit((u & 127) >> 2, u & 3, u >> 7, U, KVM, a.g_ch, Y, (mx::ldsp)lds);
#else
        for (int wu = bx * 8 + wave; wu < 4096; wu += nb * 8) mem_naive_wave(wu, U, KVM, a.g_ch, Y, lane);
#endif
    }
    grid.sync();

    { pg8::Gemm g{Y, WO, M, DM, DM}; pg8::StaticOrder S; S.init(M, DM, nb, bx);
      pg8::EpiF32 E{a.out, DM};
      pg8::gemm_phase<pg8::EpiF32, pg8::StaticOrder, true, true>((PG8_LAS unsigned char*)lds, g, S, E); }
    grid.sync();

    final_rows(a.x, a.g_post, a.out, bx * 8 + wave, nb * 8, lane);
}

extern "C" void kernel_launch(void* const* d_in, const int* in_sizes, int n_in, void* d_out, int out_size, void* d_ws, size_t ws_size, hipStream_t stream) {
    static int grid_blocks = 0;
    if (grid_blocks == 0) {
        if (n_in != 15 || out_size != M * DM || ws_size < WS_END) { fprintf(stderr, "kernel_launch: unexpected shapes (n_in %d out %d ws %zu)\n", n_in, out_size, ws_size); grid_blocks = -1; return; }
        int dev = 0, cus = 0, per_cu = 0;
        (void)hipGetDevice(&dev); (void)hipDeviceGetAttribute(&cus, hipDeviceAttributeMultiprocessorCount, dev);
        if (hipFuncSetAttribute((const void*)hybrid_fwd, hipFuncAttributeMaxDynamicSharedMemorySize, LDS_BYTES) != hipSuccess) { fprintf(stderr, "kernel_launch: hipFuncSetAttribute failed\n"); grid_blocks = -1; return; }
        if (hipOccupancyMaxActiveBlocksPerMultiprocessor(&per_cu, (const void*)hybrid_fwd, 512, LDS_BYTES) != hipSuccess || per_cu < 1) { fprintf(stderr, "kernel_launch: occupancy query says %d blocks per CU\n", per_cu); per_cu = 1; }
        (void)hipGetLastError();
        if (per_cu > 1) per_cu = 1;
        grid_blocks = cus * per_cu;
    }
    if (grid_blocks < 0) return;
    Args a{};
    a.x = (const float*)d_in[0]; a.mem = (const float*)d_in[1]; a.g_pre = (const float*)d_in[2]; a.w_in = (const float*)d_in[3];
    a.conv_w = (const float*)d_in[4]; a.conv_b = (const float*)d_in[5]; a.i_bias = (const float*)d_in[6]; a.f_bias = (const float*)d_in[7];
    a.g_mh = (const float*)d_in[8]; a.g_sh = (const float*)d_in[9]; a.g_ch = (const float*)d_in[10]; a.g_mem = (const float*)d_in[11];
    a.w_kv = (const float*)d_in[12]; a.w_out = (const float*)d_in[13]; a.g_post = (const float*)d_in[14];
    a.out = (float*)d_out; a.ws = (unsigned char*)d_ws;
    void* args[] = {&a};
    hipError_t e = hipLaunchCooperativeKernel((const void*)hybrid_fwd, dim3(grid_blocks), dim3(512), args, LDS_BYTES, stream);
    if (e != hipSuccess) fprintf(stderr, "kernel_launch: cooperative launch failed: %s (grid %d)\n", hipGetErrorString(e), grid_blocks);
}
```

```cpp
#include <hip/hip_runtime.h>
#include <hip/hip_cooperative_groups.h>
#include <cstdio>
#include <cstdint>
namespace cg = cooperative_groups;
namespace pg8 {
#define PG8_LAS __attribute__((address_space(3)))
typedef unsigned short bf16_t;
typedef short bf16x8 __attribute__((ext_vector_type(8)));
typedef float f32x4 __attribute__((ext_vector_type(4)));
typedef unsigned u32x4 __attribute__((ext_vector_type(4)));
constexpr int BM = 256, BK = 64, HALF = 128, HTB = HALF * BK * 2  , STAGE_BYTES = 8 * HTB, NXCD = 8, WGM = 8;

__host__ __device__ __forceinline__ int lds_byte(int r, int c) { const int st = (r >> 4) * 2 + (c >> 5), rr = r & 15, cc = c & 31, ob = rr * 64 + cc * 2; return st * 1024 + (ob ^ (((ob >> 9) & 1) << 5)); }
__host__ __device__ __forceinline__ void stage_rc(int b, int& R, int& C) { const int st = b / 1024, sb = b % 1024, swz = sb ^ (((sb >> 9) & 1) << 5); R = (st >> 1) * 16 + swz / 64; C = (st & 1) * 32 + (swz % 64) / 2; }
__host__ __device__ __forceinline__ int perm32(int rho) { const int n = rho >> 4, i = rho & 15; return 8 * (i >> 2) + 4 * n + (i & 3); }

struct Unit { int pm, pn; };
struct Gemm { const bf16_t* A; const bf16_t* Bt; int M, N, K; };

struct StaticOrder {
    int nM, nN, nwg, G, c;
    __host__ __device__ void init(int M, int N, int G_, int c_) { nM = M / BM; nN = N / BM; nwg = nM * nN; G = G_; c = c_; }
    __host__ __device__ bool next(int i, Unit& u) const {
        const long L = (long)i * G + c; if (L >= nwg) return false;
        int wgid = (int)L; { const int q = nwg / NXCD, r = nwg % NXCD, xcd = wgid % NXCD, off = wgid / NXCD; wgid = (xcd < r ? xcd * (q + 1) : r * (q + 1) + (xcd - r) * q) + off; }
        const int nig = WGM * nN, gid = wgid / nig, fm = gid * WGM, gsz = (nM - fm) < WGM ? (nM - fm) : WGM;
        u.pm = fm + ((wgid % nig) % gsz); u.pn = (wgid % nig) / gsz; return true;
    }
    __device__ __forceinline__ void a_ready(const Unit&) const {}
    __device__ __forceinline__ void done(const Unit&) const {}
};

__device__ __forceinline__ unsigned cvt_pk_bf16(float lo, float hi) { unsigned r; asm volatile("v_cvt_pk_bf16_f32 %0, %1, %2" : "=v"(r) : "v"(lo), "v"(hi)); return r; }
typedef float f32x2 __attribute__((ext_vector_type(2)));
__device__ __forceinline__ f32x2 gelu_pk(f32x2 v) {
    const f32x2 av = __builtin_elementwise_abs(v), d = av * 0.2316418882f + 1.0f;
    f32x2 t; t.x = __builtin_amdgcn_rcpf(d.x); t.y = __builtin_amdgcn_rcpf(d.y);
    f32x2 q = t * 0.5307027145f + (-0.7265760135f); q = q * t + 0.7107068705f; q = q * t + (-0.142248368f); q = q * t + 0.127414796f; q = q * t;
    const f32x2 s = (v * v) * (-0.72134752044f);
    f32x2 e; e.x = __builtin_amdgcn_exp2f(s.x); e.y = __builtin_amdgcn_exp2f(s.y);
    const f32x2 m = v * (q * e), r = v - m;
    f32x2 o; o.x = v.x < 0.f ? m.x : r.x; o.y = v.y < 0.f ? m.y : r.y; return o;
}

template <int ACT  > struct EpiBf16 {
    static constexpr bool PERM = true, AFTER_DRAIN = false; static_assert(ACT == 0 || ACT == 1, "EpiBf16: ACT is 0 (none) or 1 (gelu_pk)");
    bf16_t* O; int ldc; const float* bias; int split_cols; size_t split_stride; float scale0;
    __device__ __forceinline__ void operator()(const f32x4 (&acc)[2][2][4][2], const Unit& u, int wr, int wc, int fr, int fq) const {
        const int row0 = u.pm * BM + wr * 64 + fr; int colt = u.pn * BM; bf16_t* base = O;
        float sc = 1.f; if (split_cols) { const int t = colt / split_cols; base += (size_t)t * split_stride; colt -= t * split_cols; if (t == 0) sc = scale0; }
        const int col0 = colt + wc * 32 + 8 * fq, bcol0 = u.pn * BM + wc * 32 + 8 * fq;
        f32x4 bv[2][2];
#pragma unroll
        for (int bj = 0; bj < 2; ++bj)
#pragma unroll
            for (int n = 0; n < 2; ++n) bv[bj][n] = bias ? *(const f32x4*)(bias + bcol0 + bj * HALF + 4 * n) : (f32x4){0.f, 0.f, 0.f, 0.f};
#pragma unroll
        for (int ai = 0; ai < 2; ++ai)
#pragma unroll
            for (int m = 0; m < 4; ++m) { bf16_t* rowp = base + (size_t)(row0 + ai * HALF + m * 16) * ldc + col0;
#pragma unroll
                for (int bj = 0; bj < 2; ++bj) { f32x4 v0 = acc[ai][bj][m][0] + bv[bj][0], v1 = acc[ai][bj][m][1] + bv[bj][1];
                    if (ACT == 1) { f32x2 a = gelu_pk((f32x2){v0[0], v0[1]}), b = gelu_pk((f32x2){v0[2], v0[3]}), c = gelu_pk((f32x2){v1[0], v1[1]}), d = gelu_pk((f32x2){v1[2], v1[3]});
                        v0 = (f32x4){a.x, a.y, b.x, b.y}; v1 = (f32x4){c.x, c.y, d.x, d.y}; }
                    v0 = v0 * sc; v1 = v1 * sc; u32x4 w; w.x = cvt_pk_bf16(v0[0], v0[1]); w.y = cvt_pk_bf16(v0[2], v0[3]); w.z = cvt_pk_bf16(v1[0], v1[1]); w.w = cvt_pk_bf16(v1[2], v1[3]);
                    *(u32x4*)(rowp + bj * HALF) = w; } }
    }
};
struct EpiF32 {
    static constexpr bool PERM = false, AFTER_DRAIN = false;
    float* O; int ldc;
    __device__ __forceinline__ void operator()(const f32x4 (&acc)[2][2][4][2], const Unit& u, int wr, int wc, int fr, int fq) const {
        const int col0 = u.pn * BM + wc * 32 + 4 * fq;
#pragma unroll
        for (int ai = 0; ai < 2; ++ai)
#pragma unroll
            for (int m = 0; m < 4; ++m) { const int r = ai * HALF + wr * 64 + m * 16 + fr; float* rowp = O + (size_t)(u.pm * BM + r) * ldc + col0;
#pragma unroll
                for (int bj = 0; bj < 2; ++bj)
#pragma unroll
                    for (int n = 0; n < 2; ++n) *(f32x4*)(rowp + bj * HALF + n * 16) = acc[ai][bj][m][n]; }
    }
};
template <class Epi, class Sched, bool ALIGN_EPI = false, bool SP2 = false>
__device__ __forceinline__ void gemm_phase(PG8_LAS unsigned char* lds, const Gemm g, const Sched& S, const Epi& E) {
    const int tid = threadIdx.x, wid = __builtin_amdgcn_readfirstlane(tid >> 6), lane = tid & 63, wr = wid >> 2, wc = wid & 3, fr = lane & 15, fq = lane >> 4;
    const int K = g.K, nt = K / BK;
    unsigned voffA[2], voffB[2];
#pragma unroll
    for (int i = 0; i < 2; ++i) { int R, C; stage_rc(tid * 16 + i * 8192, R, C); const int Rb = Epi::PERM ? ((R & ~31) + perm32(R & 31)) : R;
        voffA[i] = (unsigned)(R * K + C) * 2u; voffB[i] = (unsigned)(Rb * K + C) * 2u; }
    const size_t kstep = (size_t)(BK * 2);
    const size_t hstep = (size_t)HALF * K * 2;
    const size_t tstep = 2 * hstep;
    const unsigned ldsw = (unsigned)wid * 1024u;
    const int aoff = lds_byte(wr * 64 + fr, fq * 8), boff = lds_byte(wc * 32 + fr, fq * 8);
#define PG8_SA(b, h) (((b) * 2 + (h)) * HTB)
#define PG8_SB(b, h) ((4 + (b) * 2 + (h)) * HTB)
#define PG8_STAGE(bufoff, gbase, voff) do { _Pragma("unroll") for (int _i = 0; _i < 2; ++_i) \
        __builtin_amdgcn_global_load_lds((const unsigned*)((const char*)(gbase) + (voff)[_i]), (PG8_LAS unsigned*)(lds + (bufoff) + ldsw + _i * 8192), 16, 0, 0); } while (0)
#define PG8_LDA(dst, b, h) do { _Pragma("unroll") for (int m = 0; m < 4; ++m) _Pragma("unroll") for (int k = 0; k < 2; ++k) dst[m][k] = *(const PG8_LAS bf16x8*)(lds + PG8_SA(b, h) + aoff + m * 2048 + k * 1024); } while (0)
#define PG8_LDB(dst, b, h) do { _Pragma("unroll") for (int n = 0; n < 2; ++n) _Pragma("unroll") for (int k = 0; k < 2; ++k) dst[n][k] = *(const PG8_LAS bf16x8*)(lds + PG8_SB(b, h) + boff + n * 2048 + k * 1024); } while (0)
#define PG8_MMA(ai, bj, At, Bt) do { __builtin_amdgcn_s_setprio(1); _Pragma("unroll") for (int m = 0; m < 4; ++m) _Pragma("unroll") for (int n = 0; n < 2; ++n) _Pragma("unroll") for (int k = 0; k < 2; ++k) \
        acc[ai][bj][m][n] = __builtin_amdgcn_mfma_f32_16x16x32_bf16(Bt[n][k], At[m][k], acc[ai][bj][m][n], 0, 0, 0); __builtin_amdgcn_s_setprio(0); } while (0)
#define PG8_WAIT_V(n) asm volatile("s_waitcnt vmcnt(" #n ")" ::: "memory")
#define PG8_WAIT_L(n) asm volatile("s_waitcnt lgkmcnt(" #n ")" ::: "memory")
#define PG8_BAR __builtin_amdgcn_s_barrier()
#define PG8_SCHED __builtin_amdgcn_sched_barrier(0)
    Unit cur, nxt; int ui = 0;
    if (!S.next(0, cur)) return;
    f32x4 acc[2][2][4][2];
#pragma unroll
    for (int a = 0; a < 2; ++a)
#pragma unroll
        for (int b = 0; b < 2; ++b)
#pragma unroll
            for (int m = 0; m < 4; ++m)
#pragma unroll
                for (int n = 0; n < 2; ++n) acc[a][b][m][n] = (f32x4){0.f, 0.f, 0.f, 0.f};
    bf16x8 At[4][2], B0[2][2], B1[2][2];
    const char* cA = (const char*)g.A + (size_t)cur.pm * tstep; const char* cB = (const char*)g.Bt + (size_t)cur.pn * tstep;
    S.a_ready(cur);
    if constexpr (SP2) {
        PG8_STAGE(PG8_SB(0, 0), cB, voffB); PG8_STAGE(PG8_SB(0, 1), cB + hstep, voffB); PG8_STAGE(PG8_SA(0, 0), cA, voffA); PG8_STAGE(PG8_SA(0, 1), cA + hstep, voffA);
        if (wr == 1) PG8_BAR;
        PG8_WAIT_V(2); PG8_BAR;
        PG8_STAGE(PG8_SB(1, 0), cB + kstep, voffB); PG8_STAGE(PG8_SA(1, 0), cA + kstep, voffA); PG8_STAGE(PG8_SB(1, 1), cB + hstep + kstep, voffB);
        PG8_WAIT_V(6); PG8_BAR;
    } else {
        PG8_STAGE(PG8_SB(0, 0), cB, voffB); PG8_STAGE(PG8_SA(0, 0), cA, voffA); PG8_STAGE(PG8_SB(0, 1), cB + hstep, voffB); PG8_STAGE(PG8_SA(0, 1), cA + hstep, voffA);
        if (wr == 1) PG8_BAR;
        PG8_WAIT_V(4); PG8_BAR;
        PG8_STAGE(PG8_SB(1, 0), cB + kstep, voffB); PG8_STAGE(PG8_SA(1, 0), cA + kstep, voffA); PG8_STAGE(PG8_SB(1, 1), cB + hstep + kstep, voffB);
        PG8_WAIT_V(6); PG8_BAR;
    }
    for (;;) {
        const bool has_next = S.next(ui + 1, nxt);
        const char* nA = has_next ? (const char*)g.A + (size_t)nxt.pm * tstep : cA; const char* nB = has_next ? (const char*)g.Bt + (size_t)nxt.pn * tstep : cB;
        for (int t = 0; t < nt; t += 2) {
            const bool last = (t == nt - 2);
            const char* a1 = cA + (size_t)(t + 1) * kstep;
            const char* a2 = last ? nA : cA + (size_t)(t + 2) * kstep; const char* b2 = last ? nB : cB + (size_t)(t + 2) * kstep;
            const char* a3 = a2 + kstep; const char* b3 = b2 + kstep;
            if (last && has_next) S.a_ready(nxt);
            if constexpr (SP2) {
            PG8_LDB(B0, 0, 0); PG8_LDB(B1, 0, 1); PG8_SCHED; PG8_LDA(At, 0, 0); PG8_STAGE(PG8_SA(1, 1), a1 + hstep, voffA);
            PG8_WAIT_V(8); PG8_WAIT_L(0); PG8_BAR; PG8_MMA(0, 0, At, B0); PG8_MMA(0, 1, At, B1); PG8_BAR; PG8_SCHED;
            PG8_LDA(At, 0, 1); PG8_STAGE(PG8_SB(0, 0), b2, voffB); PG8_STAGE(PG8_SB(0, 1), b2 + hstep, voffB); PG8_STAGE(PG8_SA(0, 0), a2, voffA);
            PG8_WAIT_V(8); PG8_WAIT_L(0); PG8_BAR; PG8_MMA(1, 0, At, B0); PG8_MMA(1, 1, At, B1); PG8_BAR; PG8_SCHED;
            PG8_LDB(B0, 1, 0); PG8_LDB(B1, 1, 1); PG8_SCHED; PG8_LDA(At, 1, 0); PG8_STAGE(PG8_SA(0, 1), a2 + hstep, voffA);
            PG8_WAIT_V(8); PG8_WAIT_L(0); PG8_BAR; PG8_MMA(0, 0, At, B0); PG8_MMA(0, 1, At, B1); PG8_BAR; PG8_SCHED;
            PG8_LDA(At, 1, 1); PG8_STAGE(PG8_SB(1, 0), b3, voffB); PG8_STAGE(PG8_SB(1, 1), b3 + hstep, voffB); PG8_STAGE(PG8_SA(1, 0), a3, voffA);
            PG8_WAIT_V(8); PG8_WAIT_L(0); PG8_BAR; PG8_MMA(1, 0, At, B0); PG8_MMA(1, 1, At, B1); PG8_BAR; PG8_SCHED;
            } else {
            PG8_LDB(B0, 0, 0); PG8_SCHED; PG8_LDA(At, 0, 0); PG8_STAGE(PG8_SA(1, 1), a1 + hstep, voffA);
            PG8_WAIT_L(8); PG8_BAR; PG8_WAIT_L(0); PG8_MMA(0, 0, At, B0); PG8_BAR; PG8_SCHED;
            PG8_LDB(B1, 0, 1); PG8_STAGE(PG8_SB(0, 0), b2, voffB);
            PG8_BAR; PG8_WAIT_L(0); PG8_MMA(0, 1, At, B1); PG8_BAR;
            PG8_LDA(At, 0, 1); PG8_STAGE(PG8_SA(0, 0), a2, voffA);
            PG8_BAR; PG8_WAIT_L(0); PG8_MMA(1, 0, At, B0); PG8_BAR; PG8_SCHED;
            PG8_STAGE(PG8_SB(0, 1), b2 + hstep, voffB);
            PG8_WAIT_V(6); PG8_BAR; PG8_MMA(1, 1, At, B1); PG8_BAR;
            PG8_LDB(B0, 1, 0); PG8_SCHED; PG8_LDA(At, 1, 0); PG8_STAGE(PG8_SA(0, 1), a2 + hstep, voffA);
            PG8_WAIT_L(8); PG8_BAR; PG8_WAIT_L(0); PG8_MMA(0, 0, At, B0); PG8_BAR; PG8_SCHED;
            PG8_LDB(B1, 1, 1); PG8_STAGE(PG8_SB(1, 0), b3, voffB);
            PG8_BAR; PG8_WAIT_L(0); PG8_MMA(0, 1, At, B1); PG8_BAR;
            PG8_LDA(At, 1, 1); PG8_STAGE(PG8_SA(1, 0), a3, voffA);
            PG8_BAR; PG8_WAIT_L(0); PG8_MMA(1, 0, At, B0); PG8_BAR; PG8_SCHED;
            PG8_STAGE(PG8_SB(1, 1), b3 + hstep, voffB);
            PG8_WAIT_V(6); PG8_BAR; PG8_MMA(1, 1, At, B1); PG8_BAR;
            }
        }
        if constexpr (ALIGN_EPI) { if (wr == 0) PG8_BAR; }
        if constexpr (!Epi::AFTER_DRAIN) { E(acc, cur, wr, wc, fr, fq); S.done(cur); }
        if (!has_next) break;
#pragma unroll
        for (int a = 0; a < 2; ++a)
#pragma unroll
            for (int b = 0; b < 2; ++b)
#pragma unroll
                for (int m = 0; m < 4; ++m)
#pragma unroll
                    for (int n = 0; n < 2; ++n) acc[a][b][m][n] = (f32x4){0.f, 0.f, 0.f, 0.f};
        cur = nxt; cA = nA; cB = nB; ++ui;
        if constexpr (ALIGN_EPI) { if (wr == 1) PG8_BAR; }
    }
    PG8_WAIT_V(0);
    if constexpr (!ALIGN_EPI) { if (wr == 0) PG8_BAR; }
    PG8_BAR;
    if constexpr (Epi::AFTER_DRAIN) { E.fused(acc, cur, wr, wc, fr, fq, lds, wid, lane); S.done(cur); }
#undef PG8_SA
#undef PG8_SB
#undef PG8_STAGE
#undef PG8_LDA
#undef PG8_LDB
#undef PG8_MMA
#undef PG8_WAIT_V
#undef PG8_WAIT_L
#undef PG8_BAR
#undef PG8_SCHED
}
}

constexpr int BATCH = 32, SEQ = 2048, DM = 1024, M = BATCH * SEQ;
constexpr int DIN = 4104, NU = 4096;
constexpr int NMEM = 256, MMEM = BATCH * NMEM;
constexpr int UQM = 0, UKM = 512, UVM = 1024, UOM = 1536, UZM = 2048, UQS = 2560, UKS = 2816, UVS = 3072, UZS = 3328, UQC = 3584, UZC = 3840;
constexpr int WIF = 2560;
constexpr float EPS = 1e-6f;
constexpr int YM = 0, YS = 512, YC = 768;

constexpr size_t MiB = 1u << 20;
constexpr size_t WS_CTL = 0, CTL_ZERO_BYTES = 1 * MiB;
constexpr size_t WS_WIN = 2 * MiB;
constexpr size_t WS_WO = 10 * MiB;
constexpr size_t WS_WKV = 12 * MiB;
constexpr size_t WS_G = 14 * MiB;
constexpr size_t WS_MEMN = 16 * MiB;
constexpr size_t WS_KVM = 32 * MiB;
constexpr size_t WS_XN = 64 * MiB;
constexpr size_t WS_Y = 64 * MiB;
constexpr size_t WS_U = 192 * MiB;
constexpr size_t WS_END = 704 * MiB;

typedef unsigned short bf16;
typedef float f32x4 __attribute__((ext_vector_type(4)));
typedef unsigned v4u __attribute__((ext_vector_type(4)));
typedef unsigned v2u __attribute__((ext_vector_type(2)));
#define LAS __attribute__((address_space(3)))

__device__ __forceinline__ unsigned f2bf(float f) { unsigned u = __builtin_bit_cast(unsigned, f); return (u + 0x7fffu + ((u >> 16) & 1u)) >> 16; }
__device__ __forceinline__ unsigned pk2(float lo, float hi) { return f2bf(lo) | (f2bf(hi) << 16); }
__device__ __forceinline__ float bf2f(unsigned h) { return __builtin_bit_cast(float, h << 16); }
__device__ __forceinline__ float bflo(unsigned w) { return __builtin_bit_cast(float, w << 16); }
__device__ __forceinline__ float bfhi(unsigned w) { return __builtin_bit_cast(float, w & 0xffff0000u); }
__device__ __forceinline__ float wave_sum(float v) {
#pragma unroll
    for (int o = 1; o < 64; o <<= 1) v += __shfl_xor(v, o);
    return v;
}
__device__ __forceinline__ float sigmoidf_(float x) { return 1.f / (1.f + __expf(-x)); }
__device__ __forceinline__ float siluf_(float x) { return x / (1.f + __expf(-x)); }

__device__ __forceinline__ void transpose_item(const float* W, int Nsrc, int K, bf16* WT, const float* gk, float* scr, int kb, int n0_dst, int n0_src, int lane) {
    const int k0 = 64 * kb;
#pragma unroll 8
    for (int i = 0; i < 32; ++i) { const int kk = 2 * i + (lane >> 5); const float g = gk ? gk[k0 + kk] : 1.f; scr[kk * 33 + (lane & 31)] = g * W[(size_t)(k0 + kk) * Nsrc + n0_src + (lane & 31)]; }
    __builtin_amdgcn_s_waitcnt(0xC07F); asm volatile("" ::: "memory");
    const int c = lane & 7;
#pragma unroll
    for (int j = 0; j < 4; ++j) { const int n = (lane >> 3) + 8 * j; const float* s = scr + (8 * c) * 33 + n;
        v4u o; o.x = pk2(s[0 * 33], s[1 * 33]); o.y = pk2(s[2 * 33], s[3 * 33]); o.z = pk2(s[4 * 33], s[5 * 33]); o.w = pk2(s[6 * 33], s[7 * 33]);
        *(v4u*)(WT + (size_t)(n0_dst + n) * K + k0 + 8 * c) = o; }
    __builtin_amdgcn_s_waitcnt(0xC07F); asm volatile("" ::: "memory");
}

struct ProArgs {
    const float *x, *mem, *g_pre, *w_in, *i_bias, *f_bias, *g_mem, *w_mem_kv, *w_out;
    bf16 *WIN, *WO, *WKV, *XN, *MEMN; float* G;
};

template <bool GATES>
__device__ __forceinline__ void row_item4(const float* xrow, bf16* orow, float* grow, const float* wif, const float* i_bias, const float* f_bias, int lane) {
    f32x4 v[4][4]; float s[4];
#pragma unroll
    for (int r = 0; r < 4; ++r) { const f32x4* xr = (const f32x4*)(xrow + (size_t)r * DM) + lane;
#pragma unroll
        for (int j = 0; j < 4; ++j) v[r][j] = xr[64 * j]; }
#pragma unroll
    for (int r = 0; r < 4; ++r) { float t = 0.f;
#pragma unroll
        for (int j = 0; j < 4; ++j) t += (v[r][j].x * v[r][j].x + v[r][j].y * v[r][j].y) + (v[r][j].z * v[r][j].z + v[r][j].w * v[r][j].w);
        s[r] = t; }
#pragma unroll
    for (int o = 1; o < 64; o <<= 1) {
#pragma unroll
        for (int r = 0; r < 4; ++r) s[r] += __shfl_xor(s[r], o); }
#pragma unroll
    for (int r = 0; r < 4; ++r) { const float rstd = 1.f / sqrtf(s[r] * (1.f / DM) + EPS);
        unsigned long long* o8 = (unsigned long long*)(orow + (size_t)r * DM) + lane;
#pragma unroll
        for (int j = 0; j < 4; ++j) { v[r][j] = v[r][j] * rstd; o8[64 * j] = (unsigned long long)pk2(v[r][j].x, v[r][j].y) | ((unsigned long long)pk2(v[r][j].z, v[r][j].w) << 32); } }
    if (GATES) {
        float a[4][8];
#pragma unroll
        for (int r = 0; r < 4; ++r)
#pragma unroll
            for (int g = 0; g < 8; ++g) a[r][g] = 0.f;
#pragma unroll
        for (int j = 0; j < 4; ++j)
#pragma unroll
            for (int c = 0; c < 4; ++c) { const int k = 4 * (lane + 64 * j) + c; const f32x4 w0 = *(const f32x4*)(wif + k * 8), w1 = *(const f32x4*)(wif + k * 8 + 4);
#pragma unroll
                for (int r = 0; r < 4; ++r) { const float xv = v[r][j][c];
                    a[r][0] += xv * w0.x; a[r][1] += xv * w0.y; a[r][2] += xv * w0.z; a[r][3] += xv * w0.w; a[r][4] += xv * w1.x; a[r][5] += xv * w1.y; a[r][6] += xv * w1.z; a[r][7] += xv * w1.w; } }
        const bool b0 = lane & 1, b1 = lane & 2, b2 = lane & 4;
        const int gsel = 4 * (lane & 1) + 2 * ((lane >> 1) & 1) + ((lane >> 2) & 1);
#pragma unroll
        for (int r = 0; r < 4; ++r) {
            float b[4], c2[2];
#pragma unroll
            for (int i = 0; i < 4; ++i) { const float send = b0 ? a[r][i] : a[r][i + 4], keep = b0 ? a[r][i + 4] : a[r][i]; b[i] = keep + __shfl_xor(send, 1); }
#pragma unroll
            for (int i = 0; i < 2; ++i) { const float send = b1 ? b[i] : b[i + 2], keep = b1 ? b[i + 2] : b[i]; c2[i] = keep + __shfl_xor(send, 2); }
            const float send = b2 ? c2[0] : c2[1], keep = b2 ? c2[1] : c2[0]; float d = keep + __shfl_xor(send, 4);
            d += __shfl_xor(d, 8); d += __shfl_xor(d, 16); d += __shfl_xor(d, 32);
            if (lane < 8) { if (gsel < 4) grow[r * 8 + gsel] = d + i_bias[gsel];
                            else { const float xx = d + f_bias[gsel - 4]; grow[r * 8 + gsel] = fminf(xx, 0.f) - log1pf(expf(-fabsf(xx))); } }
        }
    }
}

__device__ __forceinline__ void phase_prologue(const ProArgs& a, float* sh, int nblocks, int block) {
    const int tid = threadIdx.x, lane = tid & 63, wave = tid >> 6;
    float* scr = sh + wave * 2112; float* wif = sh + 8 * 2112;
    for (int i = tid; i < 8192; i += 512) { const int k = i >> 3, g = i & 7; wif[i] = a.g_pre[k] * a.w_in[(size_t)k * DIN + WIF + g]; }
    __syncthreads();
    const int gw = block * 8 + wave, NGW = nblocks * 8;
    constexpr int I_IN = 16 * 128, I_O = 16 * 32, I_KV = 16 * 16, NIT = I_IN + I_O + I_KV;
    for (int it = gw; it < NIT; it += NGW) {
        int r = it;
        if (r < I_IN) { const int kb = r / 128, nb = r % 128, n0 = 32 * nb; transpose_item(a.w_in, DIN, DM, a.WIN, a.g_pre, scr, kb, n0, n0 + (n0 >= WIF ? 8 : 0), lane); continue; } r -= I_IN;
        if (r < I_O) { const int kb = r / 32, nb = r % 32; transpose_item(a.w_out, DM, DM, a.WO, nullptr, scr, kb, 32 * nb, 32 * nb, lane); continue; } r -= I_O;
        { const int kb = r / 16, nb = r % 16; transpose_item(a.w_mem_kv, 512, DM, a.WKV, a.g_mem, scr, kb, 32 * nb, 32 * nb, lane); }
    }
    for (int m = 4 * gw; m < M; m += 4 * NGW) row_item4<true>(a.x + (size_t)m * DM, a.XN + (size_t)m * DM, a.G + (size_t)m * 8, wif, a.i_bias, a.f_bias, lane);
    for (int m = 4 * gw; m < MMEM; m += 4 * NGW) row_item4<false>(a.mem + (size_t)m * DM, a.MEMN + (size_t)m * DM, nullptr, wif, nullptr, nullptr, lane);
}

__device__ __forceinline__ void final_rows(const float* __restrict__ x, const float* __restrict__ g_post, float* out, int gw, int NGW, int lane) {
    for (int m = gw; m < M; m += NGW) {
        const f32x4* zr = (const f32x4*)(out + (size_t)m * DM) + lane; const f32x4* xr = (const f32x4*)(x + (size_t)m * DM) + lane; const f32x4* gr = (const f32x4*)g_post + lane;
        f32x4 v[4]; float s = 0.f;
#pragma unroll
        for (int j = 0; j < 4; ++j) { v[j] = zr[64 * j]; s += (v[j].x * v[j].x + v[j].y * v[j].y) + (v[j].z * v[j].z + v[j].w * v[j].w); }
        const float rstd = 1.f / sqrtf(wave_sum(s) * (1.f / DM) + EPS);
        f32x4* orow = (f32x4*)(out + (size_t)m * DM) + lane;
#pragma unroll
        for (int j = 0; j < 4; ++j) orow[64 * j] = xr[64 * j] + v[j] * rstd * gr[64 * j];
    }
}

namespace mx {
typedef short bf16x8 __attribute__((ext_vector_type(8)));
typedef short s16x4 __attribute__((ext_vector_type(4)));
typedef float f32x16 __attribute__((ext_vector_type(16)));
typedef unsigned u32x4 __attribute__((ext_vector_type(4)));
typedef LAS unsigned char* ldsp;
#define MFMA32(a, b, c) __builtin_amdgcn_mfma_f32_32x32x16_bf16((a), (b), (c), 0, 0, 0)
__device__ __forceinline__ int crow(int r, int hi) { return (r & 3) + 8 * (r >> 2) + 4 * hi; }
__device__ __forceinline__ s16x4 vtr(ldsp p) { return __builtin_bit_cast(s16x4, __builtin_amdgcn_ds_read_tr16_b64_v4i16((LAS s16x4*)p)); }
__device__ __forceinline__ bf16x8 cat8(s16x4 lo, s16x4 hi) { return __builtin_shufflevector(lo, hi, 0, 1, 2, 3, 4, 5, 6, 7); }
__device__ __forceinline__ unsigned cvtpk(float lo, float hi) { typedef float f2 __attribute__((ext_vector_type(2))); typedef __bf16 b2 __attribute__((ext_vector_type(2))); f2 v = {lo, hi}; b2 b = __builtin_convertvector(v, b2); return __builtin_bit_cast(unsigned, b); }
__device__ __forceinline__ bf16x8 pack8(const f32x16& p, int s) {
    u32x4 w; w.x = cvtpk(p[8 * s], p[8 * s + 1]); w.y = cvtpk(p[8 * s + 2], p[8 * s + 3]); w.z = cvtpk(p[8 * s + 4], p[8 * s + 5]); w.w = cvtpk(p[8 * s + 6], p[8 * s + 7]); return __builtin_bit_cast(bf16x8, w); }
constexpr float LOG2E = 1.4426950408889634f;

__device__ __forceinline__ void stage_kv(const bf16* kbase, const bf16* vbase, size_t pitch, ldsp kslot, ldsp vslot, int wid, int lane) {
    const u32x4 kx = *(const u32x4*)(kbase + (size_t)lane * pitch + wid * 8);
    const u32x4 vx = *(const u32x4*)(vbase + (size_t)(16 * (wid & 3) + (lane >> 2)) * pitch + (wid >> 2) * 32 + (lane & 3) * 8);
    *(LAS u32x4*)(kslot + wid * 1024 + lane * 16) = kx;
    *(LAS u32x4*)(vslot + wid * 1024 + lane * 16) = vx;
}
__device__ __forceinline__ void qkt(f32x16& p0, f32x16& p1, ldsp kslot, const bf16x8 (&qr)[4], int r32, int hi) {
    const ldsp kb = kslot + hi * 1024 + r32 * 16;
    f32x16 z;
#pragma unroll
    for (int i = 0; i < 16; ++i) z[i] = 0.f;
    p0 = z; p1 = z;
#pragma unroll
    for (int d0 = 0; d0 < 4; ++d0) { const bf16x8 b0 = *(const LAS bf16x8*)(kb + d0 * 2048), b1 = *(const LAS bf16x8*)(kb + d0 * 2048 + 512);
        p0 = MFMA32(b0, qr[d0], p0); p1 = MFMA32(b1, qr[d0], p1); }
}
__device__ __forceinline__ void qkt_half(f32x16& p, ldsp kslot, const bf16x8 (&qr)[4], int half, int r32, int hi) {
    const ldsp kb = kslot + hi * 1024 + r32 * 16 + half * 512;
#pragma unroll
    for (int i = 0; i < 16; ++i) p[i] = 0.f;
#pragma unroll
    for (int d0 = 0; d0 < 4; ++d0) { const bf16x8 b0 = *(const LAS bf16x8*)(kb + d0 * 2048); p = MFMA32(b0, qr[d0], p); }
}
__device__ __forceinline__ void pv64(f32x16 (&o)[2], ldsp vslot, const bf16x8 (&pa)[4], int lane, int hi) {
    const ldsp vb = vslot + ((lane >> 4) & 1) * 32 + (lane & 3) * 8 + (4 * hi + ((lane & 15) >> 2)) * 64;
#pragma unroll
    for (int d0 = 0; d0 < 2; ++d0)
#pragma unroll
        for (int ks = 0; ks < 4; ++ks) { const s16x4 lo = vtr(vb + d0 * 4096 + ks * 1024), h4 = vtr(vb + d0 * 4096 + ks * 1024 + 512); o[d0] = MFMA32(pa[ks], cat8(lo, h4), o[d0]); }
}
template <bool MASK> __device__ __forceinline__ float sb_half(f32x16& y, float base, int s0, int t, int hi) {
    float sp[16];
#pragma unroll
    for (int r = 0; r < 16; ++r) { const float v = y[r]; float s = fmaxf(v, 0.f) + __builtin_amdgcn_logf(1.f + __builtin_amdgcn_exp2f(-fabsf(v)));
        if (MASK) { if (!(s0 + crow(r, hi) < t)) s = 0.f; } sp[r] = s; }
    float bs[4], ot[4];
#pragma unroll
    for (int g = 0; g < 4; ++g) { bs[g] = (sp[4 * g] + sp[4 * g + 1]) + (sp[4 * g + 2] + sp[4 * g + 3]); ot[g] = __shfl_xor(bs[g], 32); }
    float so[4]; so[3] = 0.f; so[2] = bs[3] + ot[3]; so[1] = so[2] + (bs[2] + ot[2]); so[0] = so[1] + (bs[1] + ot[1]);
    const float total = so[0] + (bs[0] + ot[0]);
#pragma unroll
    for (int g = 0; g < 4; ++g) { const float e = base + so[g] + (hi == 0 ? ot[g] : 0.f);
        const float c3 = e + sp[4 * g + 3], c2 = c3 + sp[4 * g + 2], c1 = c2 + sp[4 * g + 1], c0 = c1 + sp[4 * g];
        float a0 = __builtin_amdgcn_exp2f(y[4 * g] - c0), a1 = __builtin_amdgcn_exp2f(y[4 * g + 1] - c1), a2 = __builtin_amdgcn_exp2f(y[4 * g + 2] - c2), a3 = __builtin_amdgcn_exp2f(y[4 * g + 3] - c3);
        if (MASK) { if (!(s0 + crow(4 * g, hi) < t)) a0 = 0.f; if (!(s0 + crow(4 * g + 1, hi) < t)) a1 = 0.f; if (!(s0 + crow(4 * g + 2, hi) < t)) a2 = 0.f; if (!(s0 + crow(4 * g + 3, hi) < t)) a3 = 0.f; }
        y[4 * g] = a0; y[4 * g + 1] = a1; y[4 * g + 2] = a2; y[4 * g + 3] = a3; }
    return total;
}
constexpr int ATT_K = 0, ATT_V = 32768, ATT_STG = 65536, ATT_STG_W = 8320, ATT_FLAG = ATT_STG + 8 * ATT_STG_W;
constexpr float SB_THR = 127.f;

__device__ __forceinline__ void attn_epilogue(const f32x16 (&o)[2], LAS float* stg, float rs, const float* __restrict__ gain, const bf16* __restrict__ zrow, bf16* __restrict__ yrow, int r32, int hi) {
#pragma unroll
    for (int d0 = 0; d0 < 2; ++d0)
#pragma unroll
        for (int r = 0; r < 16; ++r) stg[crow(r, hi) * 65 + d0 * 32 + r32] = o[d0][r];
    __builtin_amdgcn_s_waitcnt(0xC07F); asm volatile("" ::: "memory");
    float v[32]; float ss = 0.f;
#pragma unroll
    for (int i = 0; i < 32; ++i) { v[i] = stg[r32 * 65 + hi * 32 + i] * rs; ss += v[i] * v[i]; }
    ss += __shfl_xor(ss, 32);
    const float rn = 1.f / sqrtf(ss * (1.f / 64.f) + EPS);
#pragma unroll
    for (int c = 0; c < 4; ++c) { const u32x4 zw = *(const u32x4*)(zrow + hi * 32 + c * 8); const f32x4 g0 = *(const f32x4*)(gain + hi * 32 + c * 8), g1 = *(const f32x4*)(gain + hi * 32 + c * 8 + 4);
        u32x4 ow;
        ow.x = cvtpk(v[8 * c] * rn * g0.x * siluf_(bflo(zw.x)), v[8 * c + 1] * rn * g0.y * siluf_(bfhi(zw.x)));
        ow.y = cvtpk(v[8 * c + 2] * rn * g0.z * siluf_(bflo(zw.y)), v[8 * c + 3] * rn * g0.w * siluf_(bfhi(zw.y)));
        ow.z = cvtpk(v[8 * c + 4] * rn * g1.x * siluf_(bflo(zw.z)), v[8 * c + 5] * rn * g1.y * siluf_(bfhi(zw.z)));
        ow.w = cvtpk(v[8 * c + 6] * rn * g1.z * siluf_(bflo(zw.w)), v[8 * c + 7] * rn * g1.w * siluf_(bfhi(zw.w)));
        *(u32x4*)(yrow + hi * 32 + c * 8) = ow; }
}

__device__ __forceinline__ void sb_unit(int b, int h, int qb, const bf16* __restrict__ U, const float* __restrict__ g_head, bf16* __restrict__ Y, ldsp lds) {
    const int tid = threadIdx.x, lane = tid & 63, r32 = lane & 31, hi = lane >> 5, wid = __builtin_amdgcn_readfirstlane(tid >> 6);
    const size_t row0 = (size_t)b * SEQ; const int q0 = qb * 256, qw = q0 + 32 * wid, t = qw + r32;
    LAS unsigned* flag = (LAS unsigned*)(lds + ATT_FLAG);
    const bf16* Kg = U + row0 * NU + UKS + h * 64; const bf16* Vg = U + row0 * NU + UVS + h * 64;
    bf16x8 qr[4];
#pragma unroll
    for (int d0 = 0; d0 < 4; ++d0) qr[d0] = *(const bf16x8*)(U + (row0 + t) * NU + UQS + h * 64 + d0 * 16 + hi * 8);
    f32x16 o[2];
#pragma unroll
    for (int i = 0; i < 16; ++i) { o[0][i] = 0.f; o[1][i] = 0.f; }
    float R = 0.f; bool done = false;
    const int my_jt = qw >> 6;
    if (tid < 8) flag[tid] = 0u;
#pragma unroll 1
    for (int jt = 4 * qb + 3; jt >= 0; --jt) {
        __syncthreads();
        { unsigned all = 1u;
#pragma unroll
          for (int i = 0; i < 8; ++i) all &= flag[i];
          if (all) break; }
        stage_kv(Kg + (size_t)jt * 64 * NU, Vg + (size_t)jt * 64 * NU, NU, lds + ATT_K, lds + ATT_V, wid, lane);
        __syncthreads();
        if (jt <= my_jt && !done) {
            bf16x8 pa[4]; f32x16 p; float t1, t0;
            qkt_half(p, lds + ATT_K, qr, 1, r32, hi);
#pragma unroll
            for (int i = 0; i < 16; ++i) p[i] *= 0.125f * LOG2E;
            if (jt == my_jt) t1 = sb_half<true>(p, R, jt * 64 + 32, t, hi); else t1 = sb_half<false>(p, R, jt * 64 + 32, t, hi);
            pa[2] = pack8(p, 0); pa[3] = pack8(p, 1);
            qkt_half(p, lds + ATT_K, qr, 0, r32, hi);
#pragma unroll
            for (int i = 0; i < 16; ++i) p[i] *= 0.125f * LOG2E;
            if (jt == my_jt) t0 = sb_half<true>(p, R + t1, jt * 64, t, hi); else t0 = sb_half<false>(p, R + t1, jt * 64, t, hi);
            pa[0] = pack8(p, 0); pa[1] = pack8(p, 1);
            R += t1 + t0;
            pv64(o, lds + ATT_V, pa, lane, hi);
            done = __all(R >= SB_THR) != 0;
        }
        if (lane == 0 && done) flag[wid] = 1u;
    }
    attn_epilogue(o, (LAS float*)(lds + ATT_STG + wid * ATT_STG_W), 1.f, g_head + h * 64, U + (row0 + t) * NU + UZS + h * 64, Y + (row0 + t) * DM + YS + h * 64, r32, hi);
    __syncthreads();
}

__device__ __forceinline__ void mem_unit(int b, int h, int qb, const bf16* __restrict__ U, const bf16* __restrict__ KVM, const float* __restrict__ g_head, bf16* __restrict__ Y, ldsp lds) {
    const int tid = threadIdx.x, lane = tid & 63, r32 = lane & 31, hi = lane >> 5, wid = __builtin_amdgcn_readfirstlane(tid >> 6);
    const size_t row0 = (size_t)b * SEQ; const int t = qb * 256 + 32 * wid + r32;
    const bf16* Kg = KVM + (size_t)b * NMEM * 512 + h * 64; const bf16* Vg = Kg + 256;
#pragma unroll
    for (int jt = 0; jt < 4; ++jt) stage_kv(Kg + (size_t)jt * 64 * 512, Vg + (size_t)jt * 64 * 512, 512, lds + ATT_K + jt * 8192, lds + ATT_V + jt * 8192, wid, lane);
    bf16x8 qr[4];
#pragma unroll
    for (int d0 = 0; d0 < 4; ++d0) qr[d0] = *(const bf16x8*)(U + (row0 + t) * NU + UQC + h * 64 + d0 * 16 + hi * 8);
    __syncthreads();
    float mx_ = -3.0e38f;
#pragma unroll 1
    for (int jt = 0; jt < 4; ++jt) { f32x16 p0, p1; qkt(p0, p1, lds + ATT_K + jt * 8192, qr, r32, hi);
#pragma unroll
        for (int i = 0; i < 16; ++i) mx_ = fmaxf(mx_, fmaxf(p0[i], p1[i])); }
    mx_ = fmaxf(mx_, __shfl_xor(mx_, 32));
    const float mc = mx_ * (0.125f * LOG2E);
    f32x16 o[2];
#pragma unroll
    for (int i = 0; i < 16; ++i) { o[0][i] = 0.f; o[1][i] = 0.f; }
    float l = 0.f;
#pragma unroll 1
    for (int jt = 0; jt < 4; ++jt) { f32x16 p0, p1; qkt(p0, p1, lds + ATT_K + jt * 8192, qr, r32, hi);
#pragma unroll
        for (int i = 0; i < 16; ++i) { p0[i] = __builtin_amdgcn_exp2f(p0[i] * (0.125f * LOG2E) - mc); p1[i] = __builtin_amdgcn_exp2f(p1[i] * (0.125f * LOG2E) - mc); l += p0[i] + p1[i]; }
        bf16x8 pa[4]; pa[0] = pack8(p0, 0); pa[1] = pack8(p0, 1); pa[2] = pack8(p1, 0); pa[3] = pack8(p1, 1);
        pv64(o, lds + ATT_V + jt * 8192, pa, lane, hi); }
    l += __shfl_xor(l, 32);
    attn_epilogue(o, (LAS float*)(lds + ATT_STG + wid * ATT_STG_W), 1.f / l, g_head + h * 64, U + (row0 + t) * NU + UZC + h * 64, Y + (row0 + t) * DM + YC + h * 64, r32, hi);
    __syncthreads();
}
}

namespace ml {
using namespace mx;
constexpr int QK_CS = 1040;
constexpr int V_BS = 4160;
constexpr int ML_Q = 0, ML_K = 16640, ML_V = 33280, ML_VW = 49920, ML_CT = 66560, ML_H = 99328, H_LD = 132, ML_TAB = ML_H + 64 * H_LD * 4;
constexpr int T_A2 = 0, T_N = 64, T_CW = 192, T_SCR = T_CW + 1280, T_NS = T_SCR + 512, T_END = T_NS + 1024;
static_assert(ML_TAB + T_END * 4 <= 147456 - 64, "mLSTM LDS map");

__device__ __forceinline__ void mlstm_unit(int b, int h, const bf16* __restrict__ U, const float* __restrict__ G, const float* __restrict__ conv_w, const float* __restrict__ conv_b,
                                           const float* __restrict__ g_head, bf16* __restrict__ Y, ldsp lds) {
    const int tid = threadIdx.x, lane = tid & 63, r32 = lane & 31, hi = lane >> 5, wid = __builtin_amdgcn_readfirstlane(tid >> 6);
    const size_t row0 = (size_t)b * SEQ;
    LAS float* tab = (LAS float*)(lds + ML_TAB);
    LAS float* Hst = (LAS float*)(lds + ML_H);
    for (int i = tid; i < 2048; i += 512) *(LAS u32x4*)(lds + ML_CT + i * 16) = (u32x4){0u, 0u, 0u, 0u};
    if (tid < 128) tab[T_N + tid] = 0.f;
    for (int i = tid; i < 1280; i += 512) { float v;
        if (i < 512) v = conv_w[(i >> 7) * 1024 + h * 128 + (i & 127)];
        else if (i < 1024) v = conv_w[((i - 512) >> 7) * 1024 + 512 + h * 128 + (i & 127)];
        else if (i < 1152) v = conv_b[h * 128 + (i & 127)]; else v = conv_b[512 + h * 128 + (i & 127)];
        tab[T_CW + i] = v; }
    f32x16 Cacc[2];
#pragma unroll
    for (int i = 0; i < 16; ++i) { Cacc[0][i] = 0.f; Cacc[1][i] = 0.f; }
    float m_prev = 0.f;
    const int qblk = wid & 1, eq = wid >> 1, dblk = wid & 3, epair = wid >> 2;
    const int ch = tid & 15, rg = tid >> 4;
    __syncthreads();
#pragma unroll 1
    for (int c = 0; c < SEQ / 64; ++c) {
        const int t0 = c * 64;
        float bcum, a_, Mt, wend, iw, em, decay, m_new;
        { const float lf = G[(row0 + t0 + lane) * 8 + 4 + h], ip = G[(row0 + t0 + lane) * 8 + h];
          bcum = lf;
#pragma unroll
          for (int off = 1; off < 64; off <<= 1) { const float y = __shfl_up(bcum, off); if (lane >= off) bcum += y; }
          a_ = ip - bcum; float pm = a_;
#pragma unroll
          for (int off = 1; off < 64; off <<= 1) { const float y = __shfl_up(pm, off); if (lane >= off) pm = fmaxf(pm, y); }
          Mt = fmaxf(m_prev, pm); const float Mlast = __shfl(Mt, 63), blast = __shfl(bcum, 63);
          wend = expf(a_ - Mlast); iw = expf(m_prev - Mt); em = expf(-bcum - Mt); decay = expf(m_prev - Mlast); m_new = blast + Mlast;
          if (wid == 0) tab[T_A2 + lane] = a_ * LOG2E; }
        { const int rA = 2 * rg;
          const size_t gbase = (row0 + t0 + rA) * (size_t)NU + h * 128 + 8 * ch;
#pragma unroll
          for (int which = 0; which < 2; ++which) {
              const bf16* src = U + gbase + (which ? UKM : UQM);
              float x[5][8];
#pragma unroll
              for (int i = 0; i < 5; ++i) { const int trel = t0 + rA - 3 + i;
                  u32x4 w = (u32x4){0u, 0u, 0u, 0u}; if (trel >= 0) w = *(const u32x4*)(src + (ptrdiff_t)(i - 3) * NU);
                  x[i][0] = bflo(w.x); x[i][1] = bfhi(w.x); x[i][2] = bflo(w.y); x[i][3] = bfhi(w.y); x[i][4] = bflo(w.z); x[i][5] = bfhi(w.z); x[i][6] = bflo(w.w); x[i][7] = bfhi(w.w); }
              const LAS float* cw = tab + T_CW + which * 512 + 8 * ch; const LAS float* cb = tab + T_CW + 1024 + which * 128 + 8 * ch;
              float o0[8], o1[8];
#pragma unroll
              for (int d = 0; d < 8; ++d) { o0[d] = cb[d]; o1[d] = cb[d]; }
#pragma unroll
              for (int j = 0; j < 4; ++j)
#pragma unroll
                  for (int d = 0; d < 8; ++d) { const float wj = cw[j * 128 + d]; o0[d] += wj * x[j][d]; o1[d] += wj * x[j + 1][d]; }
              const float sc = which ? 0.08838834764831845f : 1.f;
#pragma unroll
              for (int d = 0; d < 8; ++d) { o0[d] = siluf_(o0[d]) * sc; o1[d] = siluf_(o1[d]) * sc; }
              u32x4 w0, w1; w0.x = cvtpk(o0[0], o0[1]); w0.y = cvtpk(o0[2], o0[3]); w0.z = cvtpk(o0[4], o0[5]); w0.w = cvtpk(o0[6], o0[7]);
              w1.x = cvtpk(o1[0], o1[1]); w1.y = cvtpk(o1[2], o1[3]); w1.z = cvtpk(o1[4], o1[5]); w1.w = cvtpk(o1[6], o1[7]);
              const ldsp dst = lds + (which ? ML_K : ML_Q) + ch * QK_CS + rA * 16;
              *(LAS u32x4*)dst = w0; *(LAS u32x4*)(dst + 16) = w1; }
          const float we0 = __shfl(wend, rA), we1 = __shfl(wend, rA + 1);
          const bf16* vsrc = U + gbase + UVM;
          const u32x4 v0 = *(const u32x4*)vsrc, v1 = *(const u32x4*)(vsrc + NU);
          const ldsp vd = lds + ML_V + (ch >> 2) * V_BS + rA * 64 + (ch & 3) * 16; const ldsp vwd = vd + (ML_VW - ML_V);
          *(LAS u32x4*)vd = v0; *(LAS u32x4*)(vd + 64) = v1;
          u32x4 s0, s1;
          s0.x = cvtpk(bflo(v0.x) * we0, bfhi(v0.x) * we0); s0.y = cvtpk(bflo(v0.y) * we0, bfhi(v0.y) * we0); s0.z = cvtpk(bflo(v0.z) * we0, bfhi(v0.z) * we0); s0.w = cvtpk(bflo(v0.w) * we0, bfhi(v0.w) * we0);
          s1.x = cvtpk(bflo(v1.x) * we1, bfhi(v1.x) * we1); s1.y = cvtpk(bflo(v1.y) * we1, bfhi(v1.y) * we1); s1.z = cvtpk(bflo(v1.z) * we1, bfhi(v1.z) * we1); s1.w = cvtpk(bflo(v1.w) * we1, bfhi(v1.w) * we1);
          *(LAS u32x4*)vwd = s0; *(LAS u32x4*)(vwd + 64) = s1; }
        __syncthreads();
        {
            const int tq = 32 * qblk + r32;
            const float M2 = __shfl(Mt, tq) * LOG2E, iw_q = __shfl(iw, tq), em_q = __shfl(em, tq);
            bf16x8 qf[8];
#pragma unroll
            for (int ks = 0; ks < 8; ++ks) qf[ks] = *(const LAS bf16x8*)(lds + ML_Q + (2 * ks + hi) * QK_CS + tq * 16);
            f32x16 osv, oqc;
#pragma unroll
            for (int i = 0; i < 16; ++i) { osv[i] = 0.f; oqc[i] = 0.f; }
            float den = 0.f;
            const ldsp vb = lds + ML_V + eq * V_BS + ((lane >> 4) & 1) * 32 + (lane & 3) * 8 + (4 * hi + ((lane & 15) >> 2)) * 64;
#pragma unroll
            for (int kt = 0; kt < 2; ++kt) {
                if (kt <= qblk) {
                    f32x16 p;
#pragma unroll
                    for (int i = 0; i < 16; ++i) p[i] = 0.f;
#pragma unroll
                    for (int ks = 0; ks < 8; ++ks) { const bf16x8 kf = *(const LAS bf16x8*)(lds + ML_K + (2 * ks + hi) * QK_CS + (32 * kt + r32) * 16); p = MFMA32(kf, qf[ks], p); }
#pragma unroll
                    for (int g = 0; g < 4; ++g) { const f32x4 a4 = *(const LAS f32x4*)(tab + T_A2 + 32 * kt + 8 * g + 4 * hi);
#pragma unroll
                        for (int j = 0; j < 4; ++j) { float w = __builtin_amdgcn_exp2f(a4[j] - M2); if (kt == qblk) { if (8 * g + 4 * hi + j > r32) w = 0.f; }
                            const float v = p[4 * g + j] * w; p[4 * g + j] = v; den += v; } }
                    const bf16x8 pa0 = pack8(p, 0), pa1 = pack8(p, 1);
                    { const s16x4 lo = vtr(vb + (2 * kt) * 1024), h4 = vtr(vb + (2 * kt) * 1024 + 512); osv = MFMA32(pa0, cat8(lo, h4), osv); }
                    { const s16x4 lo = vtr(vb + (2 * kt + 1) * 1024), h4 = vtr(vb + (2 * kt + 1) * 1024 + 512); osv = MFMA32(pa1, cat8(lo, h4), osv); }
                }
            }
            den += __shfl_xor(den, 32);
            float qn = 0.f;
#pragma unroll
            for (int ks = 0; ks < 8; ++ks) { const bf16x8 kf = *(const LAS bf16x8*)(lds + ML_CT + (2 * ks + hi) * 2048 + (32 * eq + r32) * 16); oqc = MFMA32(qf[ks], kf, oqc);
                const f32x4 n0 = *(const LAS f32x4*)(tab + T_N + 16 * ks + 8 * hi), n1 = *(const LAS f32x4*)(tab + T_N + 16 * ks + 8 * hi + 4);
                const u32x4 qw = __builtin_bit_cast(u32x4, qf[ks]);
                qn += bflo(qw.x) * n0.x + bfhi(qw.x) * n0.y + bflo(qw.y) * n0.z + bfhi(qw.y) * n0.w + bflo(qw.z) * n1.x + bfhi(qw.z) * n1.y + bflo(qw.w) * n1.z + bfhi(qw.w) * n1.w; }
            qn += __shfl_xor(qn, 32);
            const float dinv = 1.f / fmaxf(fabsf(den + iw_q * qn), em_q);
            LAS float* scr = tab + T_SCR + wid * 64;
            if (hi == 0) { scr[r32] = iw_q; scr[32 + r32] = dinv; }
            __builtin_amdgcn_s_waitcnt(0xC07F); asm volatile("" ::: "memory");
#pragma unroll
            for (int g = 0; g < 4; ++g) { const f32x4 i4 = *(const LAS f32x4*)(scr + 8 * g + 4 * hi), d4 = *(const LAS f32x4*)(scr + 32 + 8 * g + 4 * hi);
#pragma unroll
                for (int j = 0; j < 4; ++j) Hst[(32 * qblk + 8 * g + 4 * hi + j) * H_LD + 32 * eq + r32] = (osv[4 * g + j] + i4[j] * oqc[4 * g + j]) * d4[j]; }
        }
        {
            const int blk = (lane >> 4) & 1, q4 = (lane & 15) >> 2, p4 = lane & 3;
            const ldsp ka = lds + ML_K + (4 * dblk + 2 * blk + (p4 >> 1)) * QK_CS + (4 * hi + q4) * 16 + (p4 & 1) * 8;
            const ldsp vwb = lds + ML_VW + (2 * epair) * V_BS + blk * 32 + p4 * 8 + (4 * hi + q4) * 64;
#pragma unroll
            for (int i = 0; i < 16; ++i) { Cacc[0][i] *= decay; Cacc[1][i] *= decay; }
#pragma unroll
            for (int ks = 0; ks < 4; ++ks) { const bf16x8 af = cat8(vtr(ka + ks * 256), vtr(ka + ks * 256 + 128));
                const bf16x8 b0 = cat8(vtr(vwb + ks * 1024), vtr(vwb + ks * 1024 + 512)), b1 = cat8(vtr(vwb + V_BS + ks * 1024), vtr(vwb + V_BS + ks * 1024 + 512));
                Cacc[0] = MFMA32(af, b0, Cacc[0]); Cacc[1] = MFMA32(af, b1, Cacc[1]); }
            const float we0 = __shfl(wend, 2 * rg), we1 = __shfl(wend, 2 * rg + 1);
            const u32x4 k0 = *(const LAS u32x4*)(lds + ML_K + ch * QK_CS + (2 * rg) * 16), k1 = *(const LAS u32x4*)(lds + ML_K + ch * QK_CS + (2 * rg + 1) * 16);
            float np_[8];
            np_[0] = bflo(k0.x) * we0 + bflo(k1.x) * we1; np_[1] = bfhi(k0.x) * we0 + bfhi(k1.x) * we1; np_[2] = bflo(k0.y) * we0 + bflo(k1.y) * we1; np_[3] = bfhi(k0.y) * we0 + bfhi(k1.y) * we1;
            np_[4] = bflo(k0.z) * we0 + bflo(k1.z) * we1; np_[5] = bfhi(k0.z) * we0 + bfhi(k1.z) * we1; np_[6] = bflo(k0.w) * we0 + bflo(k1.w) * we1; np_[7] = bfhi(k0.w) * we0 + bfhi(k1.w) * we1;
#pragma unroll
            for (int d = 0; d < 8; ++d) { np_[d] += __shfl_xor(np_[d], 16); np_[d] += __shfl_xor(np_[d], 32); }
            if (lane < 16) {
#pragma unroll
                for (int d = 0; d < 8; ++d) tab[T_NS + wid * 128 + 8 * lane + d] = np_[d]; }
        }
        __syncthreads();
        {
#pragma unroll
            for (int i = 0; i < 2; ++i)
#pragma unroll
                for (int g = 0; g < 4; ++g) { typedef unsigned u32x2 __attribute__((ext_vector_type(2))); u32x2 w; w.x = cvtpk(Cacc[i][4 * g], Cacc[i][4 * g + 1]); w.y = cvtpk(Cacc[i][4 * g + 2], Cacc[i][4 * g + 3]);
                    *(LAS u32x2*)(lds + ML_CT + (4 * dblk + g) * 2048 + (32 * (2 * epair + i) + r32) * 16 + 8 * hi) = w; }
            if (tid < 128) { float s = decay * tab[T_N + tid];
#pragma unroll
                for (int w = 0; w < 8; ++w) s += tab[T_NS + w * 128 + tid];
                tab[T_N + tid] = s; }
            const int t = tid >> 3, e0 = 16 * (tid & 7);
            float hv[16]; float ss = 0.f;
#pragma unroll
            for (int i = 0; i < 4; ++i) { const f32x4 x = *(const LAS f32x4*)(Hst + t * H_LD + e0 + 4 * i); hv[4 * i] = x.x; hv[4 * i + 1] = x.y; hv[4 * i + 2] = x.z; hv[4 * i + 3] = x.w; ss += (x.x * x.x + x.y * x.y) + (x.z * x.z + x.w * x.w); }
            ss += __shfl_xor(ss, 1); ss += __shfl_xor(ss, 2); ss += __shfl_xor(ss, 4);
            const float rn = 1.f / sqrtf(ss * (1.f / 128.f) + EPS);
            const size_t row = row0 + t0 + t;
            const bf16* op = U + row * NU + UOM + h * 128 + e0; const bf16* zp = U + row * NU + UZM + h * 128 + e0; const float* gp = g_head + h * 128 + e0;
            bf16* yp = Y + row * DM + YM + h * 128 + e0;
#pragma unroll
            for (int c2 = 0; c2 < 2; ++c2) { const u32x4 ow = *(const u32x4*)(op + 8 * c2), zw = *(const u32x4*)(zp + 8 * c2); const f32x4 g0 = *(const f32x4*)(gp + 8 * c2), g1 = *(const f32x4*)(gp + 8 * c2 + 4);
                u32x4 yw;
                yw.x = cvtpk(sigmoidf_(bflo(ow.x)) * hv[8 * c2] * rn * g0.x * siluf_(bflo(zw.x)), sigmoidf_(bfhi(ow.x)) * hv[8 * c2 + 1] * rn * g0.y * siluf_(bfhi(zw.x)));
                yw.y = cvtpk(sigmoidf_(bflo(ow.y)) * hv[8 * c2 + 2] * rn * g0.z * siluf_(bflo(zw.y)), sigmoidf_(bfhi(ow.y)) * hv[8 * c2 + 3] * rn * g0.w * siluf_(bfhi(zw.y)));
                yw.z = cvtpk(sigmoidf_(bflo(ow.z)) * hv[8 * c2 + 4] * rn * g1.x * siluf_(bflo(zw.z)), sigmoidf_(bfhi(ow.z)) * hv[8 * c2 + 5] * rn * g1.y * siluf_(bfhi(zw.z)));
                yw.w = cvtpk(sigmoidf_(bflo(ow.w)) * hv[8 * c2 + 6] * rn * g1.z * siluf_(bflo(zw.w)), sigmoidf_(bfhi(ow.w)) * hv[8 * c2 + 7] * rn * g1.w * siluf_(bfhi(zw.w)));
                *(u32x4*)(yp + 8 * c2) = yw; }
        }
        m_prev = m_new;
    }
    __syncthreads();
}
}
#define XB_TMO      128
#define XB_XCNT(j)  (256  + 64 * (j))
#define XB_XSUB(j)  (1280 + 64 * (j))
#define XB_XGEN(j)  (2304 + 64 * (j))
#define XB_TOP      3328
#define XB_TOPGEN   3392
#define XCD_BAR_WORDS 3456
#define XB_SPIN_CAP (1u << 18)

__device__ __forceinline__ unsigned xb_ld(unsigned* p)              { return __hip_atomic_load(p, __ATOMIC_RELAXED, __HIP_MEMORY_SCOPE_AGENT); }
__device__ __forceinline__ unsigned xb_add(unsigned* p, unsigned v) { return __hip_atomic_fetch_add(p, v, __ATOMIC_RELAXED, __HIP_MEMORY_SCOPE_AGENT); }
__device__ __forceinline__ unsigned xb_xcc_id() { return (unsigned)__builtin_amdgcn_s_getreg((3 << 11) | 20) & 0xFu; }
#define XB_SPIN(cond, bar) do { unsigned _sp = 0; while (cond) { __builtin_amdgcn_s_sleep(1); \
    if ((++_sp & 255u) == 0u) { if (xb_ld(&(bar)[XB_TMO])) break; if (_sp > XB_SPIN_CAP) { atomicAdd(&(bar)[XB_TMO], 1u); break; } } } } while (0)

struct XcdBarrier {
    unsigned* bar; unsigned x;
    volatile LAS unsigned* st;
};

__device__ __forceinline__ XcdBarrier xcd_barrier_post(unsigned* bar, volatile LAS unsigned* st) {
    XcdBarrier b; b.bar = bar; b.x = xb_xcc_id(); b.st = st;
    if (threadIdx.x == 0) (void)xb_add(&bar[XB_XCNT(b.x)], 1u);
    return b;
}
__device__ __forceinline__ void xcd_barrier_complete(unsigned* bar, unsigned x, unsigned& nloc, unsigned& nx) {
    const unsigned G = gridDim.x * gridDim.y * gridDim.z;
    unsigned sum, cnt, mine, sp = 0u;
    for (;;) {
        sum = 0u; cnt = 0u; mine = 0u;
#pragma unroll
        for (unsigned j = 0; j < 16; ++j) { const unsigned c = xb_ld(&bar[XB_XCNT(j)]); sum += c; cnt += (c > 0u) ? 1u : 0u; mine = (j == x) ? c : mine; }
        if (sum == G) break;
        __builtin_amdgcn_s_sleep(1);
        if ((++sp & 255u) == 0u) { if (xb_ld(&bar[XB_TMO])) break; if (sp > XB_SPIN_CAP) { atomicAdd(&bar[XB_TMO], 1u); break; } }
    }
    nloc = mine > 0u ? mine : 1u; nx = cnt > 0u ? cnt : 1u;
}

__device__ __forceinline__ void xcd_barrier(const XcdBarrier& b) {
    asm volatile("s_waitcnt vmcnt(0)" ::: "memory");
    __syncthreads();
    if (threadIdx.x == 0) {
        unsigned* bar = b.bar;
        __builtin_amdgcn_s_waitcnt(0);
        unsigned nloc = b.st[0], nx = b.st[1];
        if (nloc == 0u) { xcd_barrier_complete(bar, b.x, nloc, nx); b.st[0] = nloc; b.st[1] = nx; }
        const unsigned old = xb_add(&bar[XB_XSUB(b.x)], 1u);
        const unsigned gen = old / nloc;
        if (old + 1u == (gen + 1u) * nloc) {
            __builtin_amdgcn_fence(__ATOMIC_RELEASE, "agent");
            asm volatile("s_waitcnt vmcnt(0)" ::: "memory");
            const unsigned og = xb_add(&bar[XB_TOP], 1u);
            const unsigned tg = og / nx;
            if (og + 1u == (tg + 1u) * nx) xb_add(&bar[XB_TOPGEN], 1u);
            else XB_SPIN(xb_ld(&bar[XB_TOPGEN]) == tg, bar);
            __builtin_amdgcn_fence(__ATOMIC_ACQUIRE, "agent");
            xb_add(&bar[XB_XGEN(b.x)], 1u);
            asm volatile("s_waitcnt vmcnt(0)" ::: "memory");
        } else {
            XB_SPIN(xb_ld(&bar[XB_XGEN(b.x)]) == gen, bar);
            __builtin_amdgcn_fence(__ATOMIC_ACQUIRE, "agent");
            asm volatile("s_waitcnt vmcnt(0)" ::: "memory");
        }
    }
    __syncthreads();
}

#ifndef USE_MFMA_MLSTM
#define USE_MFMA_MLSTM 1
#endif

#ifndef USE_MFMA_SB
#define USE_MFMA_SB 1
#endif
#ifndef USE_MFMA_MEM
#define USE_MFMA_MEM 1
#endif

constexpr int LDS_BYTES = 147456;
constexpr int LDS_TAIL = LDS_BYTES - 64;
constexpr int CW_QHEAD = 64, CW_BAR = 4096;
constexpr int N_ML = 128, N_SB = 1024, N_MEM = 1024, N_ITEMS = N_ML + N_SB + N_MEM;
struct Args {
    const float *x, *mem, *g_pre, *w_in, *conv_w, *conv_b, *i_bias, *f_bias, *g_mh, *g_sh, *g_ch, *g_mem, *w_kv, *w_out, *g_post;
    float* out; unsigned char* ws;
};

__global__ void __launch_bounds__(512, 2) hybrid_fwd(Args a) {
    extern __shared__ __attribute__((aligned(16))) unsigned char lds[];
    cg::grid_group grid = cg::this_grid();
    const int tid = threadIdx.x, lane = tid & 63, wave = __builtin_amdgcn_readfirstlane(tid >> 6);
    const int nb = (int)gridDim.x, bx = (int)blockIdx.x;
    unsigned char* ws = a.ws;
    unsigned* ctl = (unsigned*)(ws + WS_CTL);
    volatile LAS unsigned* tail = (volatile LAS unsigned*)((LAS unsigned char*)lds + LDS_TAIL);
    if (tid < 16) tail[tid] = 0u;
    __syncthreads();
    const XcdBarrier xbar = xcd_barrier_post(ctl + CW_BAR, tail);
    bf16* WIN = (bf16*)(ws + WS_WIN); bf16* WO = (bf16*)(ws + WS_WO); bf16* WKV = (bf16*)(ws + WS_WKV); float* G = (float*)(ws + WS_G);
    bf16* MEMN = (bf16*)(ws + WS_MEMN); bf16* KVM = (bf16*)(ws + WS_KVM); bf16* XN = (bf16*)(ws + WS_XN); bf16* Y = (bf16*)(ws + WS_Y); bf16* U = (bf16*)(ws + WS_U);

    { ProArgs pa{a.x, a.mem, a.g_pre, a.w_in, a.i_bias, a.f_bias, a.g_mem, a.w_kv, a.w_out, WIN, WO, WKV, XN, MEMN, G};
      phase_prologue(pa, (float*)lds, nb, bx); }
    grid.sync();

    { pg8::Gemm g{XN, WIN, M, NU, DM}; pg8::StaticOrder S; S.init(M, NU, nb, bx);
      pg8::EpiBf16<0> E{U, NU, nullptr, 0, 0, 1.f};
      pg8::gemm_phase<pg8::EpiBf16<0>, pg8::StaticOrder, true, true>((PG8_LAS unsigned char*)lds, g, S, E); }
    { pg8::Gemm g{MEMN, WKV, MMEM, 512, DM}; pg8::StaticOrder S; S.init(MMEM, 512, nb, bx);
      pg8::EpiBf16<0> E{KVM, 512, nullptr, 0, 0, 1.f};
      pg8::gemm_phase<pg8::EpiBf16<0>, pg8::StaticOrder, true, true>((PG8_LAS unsigned char*)lds, g, S, E); }
    xcd_barrier(xbar);

    for (;;) {
        if (tid == 0) tail[8] = __hip_atomic_fetch_add(ctl + CW_QHEAD, 1u, __ATOMIC_RELAXED, __HIP_MEMORY_SCOPE_AGENT);
        __syncthreads();
        const int item = (int)tail[8];
        if (item >= N_ITEMS) break;
        if (item < N_ML) ml::mlstm_unit(item >> 2, item & 3, U, G, a.conv_w, a.conv_b, a.g_mh, Y, (mx::ldsp)lds);
        else if (item < N_ML + N_SB) { const int i = item - N_ML; mx::sb_unit((i & 127) >> 2, i & 3, 7 - (i >> 7), U, a.g_sh, Y, (mx::ldsp)lds); }
        else { const int i = item - N_ML - N_SB; mx::mem_unit((i & 127) >> 2, i & 3, i >> 7, U, KVM, a.g_ch, Y, (mx::ldsp)lds); }
    }
    xcd_barrier(xbar);

    { pg8::Gemm g{Y, WO, M, DM, DM}; pg8::StaticOrder S; S.init(M, DM, nb, bx);
      pg8::EpiF32 E{a.out, DM};
      pg8::gemm_phase<pg8::EpiF32, pg8::StaticOrder, true, true>((PG8_LAS unsigned char*)lds, g, S, E); }
    xcd_barrier(xbar);

    final_rows(a.x, a.g_post, a.out, bx * 8 + wave, nb * 8, lane);
}

extern "C" void kernel_launch(void* const* d_in, const int* in_sizes, int n_in, void* d_out, int out_size, void* d_ws, size_t ws_size, hipStream_t stream) {
    static int grid_blocks = 0;
    if (grid_blocks == 0) {
        if (n_in != 15 || out_size != M * DM || ws_size < WS_END) { fprintf(stderr, "kernel_launch: unexpected shapes (n_in %d out %d ws %zu)\n", n_in, out_size, ws_size); grid_blocks = -1; return; }
        int dev = 0, cus = 0, per_cu = 0;
        (void)hipGetDevice(&dev); (void)hipDeviceGetAttribute(&cus, hipDeviceAttributeMultiprocessorCount, dev);
        if (hipFuncSetAttribute((const void*)hybrid_fwd, hipFuncAttributeMaxDynamicSharedMemorySize, LDS_BYTES) != hipSuccess) { fprintf(stderr, "kernel_launch: hipFuncSetAttribute failed\n"); grid_blocks = -1; return; }
        if (hipOccupancyMaxActiveBlocksPerMultiprocessor(&per_cu, (const void*)hybrid_fwd, 512, LDS_BYTES) != hipSuccess || per_cu < 1) { fprintf(stderr, "kernel_launch: occupancy query says %d blocks per CU\n", per_cu); per_cu = 1; }
        (void)hipGetLastError();
        if (per_cu > 1) per_cu = 1;
        grid_blocks = cus * per_cu;
    }
    if (grid_blocks < 0) return;
    Args a{};
    a.x = (const float*)d_in[0]; a.mem = (const float*)d_in[1]; a.g_pre = (const float*)d_in[2]; a.w_in = (const float*)d_in[3];
    a.conv_w = (const float*)d_in[4]; a.conv_b = (const float*)d_in[5]; a.i_bias = (const float*)d_in[6]; a.f_bias = (const float*)d_in[7];
    a.g_mh = (const float*)d_in[8]; a.g_sh = (const float*)d_in[9]; a.g_ch = (const float*)d_in[10]; a.g_mem = (const float*)d_in[11];
    a.w_kv = (const float*)d_in[12]; a.w_out = (const float*)d_in[13]; a.g_post = (const float*)d_in[14];
    a.out = (float*)d_out; a.ws = (unsigned char*)d_ws;
    (void)hipMemsetAsync((char*)d_ws + WS_CTL, 0, 65536, stream);
    void* args[] = {&a};
    hipError_t e = hipLaunchCooperativeKernel((const void*)hybrid_fwd, dim3(grid_blocks), dim3(512), args, LDS_BYTES, stream);
    if (e != hipSuccess) fprintf(stderr, "kernel_launch: cooperative launch failed: %s (grid %d)\n", hipGetErrorString(e), grid_blocks);
}
```

```cpp
#include <hip/hip_runtime.h>
#include <hip/hip_cooperative_groups.h>
#include <cstdio>
#include <cstdint>
namespace cg = cooperative_groups;
namespace pg8 {
#define PG8_LAS __attribute__((address_space(3)))
typedef unsigned short bf16_t;
typedef short bf16x8 __attribute__((ext_vector_type(8)));
typedef float f32x4 __attribute__((ext_vector_type(4)));
typedef unsigned u32x4 __attribute__((ext_vector_type(4)));
constexpr int BM = 256, BK = 64, HALF = 128, HTB = HALF * BK * 2  , STAGE_BYTES = 8 * HTB, NXCD = 8, WGM = 8;

__host__ __device__ __forceinline__ int lds_byte(int r, int c) { const int st = (r >> 4) * 2 + (c >> 5), rr = r & 15, cc = c & 31, ob = rr * 64 + cc * 2; return st * 1024 + (ob ^ (((ob >> 9) & 1) << 5)); }
__host__ __device__ __forceinline__ void stage_rc(int b, int& R, int& C) { const int st = b / 1024, sb = b % 1024, swz = sb ^ (((sb >> 9) & 1) << 5); R = (st >> 1) * 16 + swz / 64; C = (st & 1) * 32 + (swz % 64) / 2; }
__host__ __device__ __forceinline__ int perm32(int rho) { const int n = rho >> 4, i = rho & 15; return 8 * (i >> 2) + 4 * n + (i & 3); }

struct Unit { int pm, pn; };
struct Gemm { const bf16_t* A; const bf16_t* Bt; int M, N, K; };

struct StaticOrder {
    int nM, nN, nwg, G, c;
    __host__ __device__ void init(int M, int N, int G_, int c_) { nM = M / BM; nN = N / BM; nwg = nM * nN; G = G_; c = c_; }
    __host__ __device__ bool next(int i, Unit& u) const {
        const long L = (long)i * G + c; if (L >= nwg) return false;
        int wgid = (int)L; { const int q = nwg / NXCD, r = nwg % NXCD, xcd = wgid % NXCD, off = wgid / NXCD; wgid = (xcd < r ? xcd * (q + 1) : r * (q + 1) + (xcd - r) * q) + off; }
        const int nig = WGM * nN, gid = wgid / nig, fm = gid * WGM, gsz = (nM - fm) < WGM ? (nM - fm) : WGM;
        u.pm = fm + ((wgid % nig) % gsz); u.pn = (wgid % nig) / gsz; return true;
    }
    __device__ __forceinline__ void a_ready(const Unit&) const {}
    __device__ __forceinline__ void done(const Unit&) const {}
};

__device__ __forceinline__ unsigned cvt_pk_bf16(float lo, float hi) { unsigned r; asm volatile("v_cvt_pk_bf16_f32 %0, %1, %2" : "=v"(r) : "v"(lo), "v"(hi)); return r; }
typedef float f32x2 __attribute__((ext_vector_type(2)));
__device__ __forceinline__ f32x2 gelu_pk(f32x2 v) {
    const f32x2 av = __builtin_elementwise_abs(v), d = av * 0.2316418882f + 1.0f;
    f32x2 t; t.x = __builtin_amdgcn_rcpf(d.x); t.y = __builtin_amdgcn_rcpf(d.y);
    f32x2 q = t * 0.5307027145f + (-0.7265760135f); q = q * t + 0.7107068705f; q = q * t + (-0.142248368f); q = q * t + 0.127414796f; q = q * t;
    const f32x2 s = (v * v) * (-0.72134752044f);
    f32x2 e; e.x = __builtin_amdgcn_exp2f(s.x); e.y = __builtin_amdgcn_exp2f(s.y);
    const f32x2 m = v * (q * e), r = v - m;
    f32x2 o; o.x = v.x < 0.f ? m.x : r.x; o.y = v.y < 0.f ? m.y : r.y; return o;
}

template <int ACT  > struct EpiBf16 {
    static constexpr bool PERM = true, AFTER_DRAIN = false; static_assert(ACT == 0 || ACT == 1, "EpiBf16: ACT is 0 (none) or 1 (gelu_pk)");
    bf16_t* O; int ldc; const float* bias; int split_cols; size_t split_stride; float scale0;
    __device__ __forceinline__ void operator()(const f32x4 (&acc)[2][2][4][2], const Unit& u, int wr, int wc, int fr, int fq) const {
        const int row0 = u.pm * BM + wr * 64 + fr; int colt = u.pn * BM; bf16_t* base = O;
        float sc = 1.f; if (split_cols) { const int t = colt / split_cols; base += (size_t)t * split_stride; colt -= t * split_cols; if (t == 0) sc = scale0; }
        const int col0 = colt + wc * 32 + 8 * fq, bcol0 = u.pn * BM + wc * 32 + 8 * fq;
        f32x4 bv[2][2];
#pragma unroll
        for (int bj = 0; bj < 2; ++bj)
#pragma unroll
            for (int n = 0; n < 2; ++n) bv[bj][n] = bias ? *(const f32x4*)(bias + bcol0 + bj * HALF + 4 * n) : (f32x4){0.f, 0.f, 0.f, 0.f};
#pragma unroll
        for (int ai = 0; ai < 2; ++ai)
#pragma unroll
            for (int m = 0; m < 4; ++m) { bf16_t* rowp = base + (size_t)(row0 + ai * HALF + m * 16) * ldc + col0;
#pragma unroll
                for (int bj = 0; bj < 2; ++bj) { f32x4 v0 = acc[ai][bj][m][0] + bv[bj][0], v1 = acc[ai][bj][m][1] + bv[bj][1];
                    if (ACT == 1) { f32x2 a = gelu_pk((f32x2){v0[0], v0[1]}), b = gelu_pk((f32x2){v0[2], v0[3]}), c = gelu_pk((f32x2){v1[0], v1[1]}), d = gelu_pk((f32x2){v1[2], v1[3]});
                        v0 = (f32x4){a.x, a.y, b.x, b.y}; v1 = (f32x4){c.x, c.y, d.x, d.y}; }
                    v0 = v0 * sc; v1 = v1 * sc; u32x4 w; w.x = cvt_pk_bf16(v0[0], v0[1]); w.y = cvt_pk_bf16(v0[2], v0[3]); w.z = cvt_pk_bf16(v1[0], v1[1]); w.w = cvt_pk_bf16(v1[2], v1[3]);
                    *(u32x4*)(rowp + bj * HALF) = w; } }
    }
};
struct EpiF32 {
    static constexpr bool PERM = false, AFTER_DRAIN = false;
    float* O; int ldc;
    __device__ __forceinline__ void operator()(const f32x4 (&acc)[2][2][4][2], const Unit& u, int wr, int wc, int fr, int fq) const {
        const int col0 = u.pn * BM + wc * 32 + 4 * fq;
#pragma unroll
        for (int ai = 0; ai < 2; ++ai)
#pragma unroll
            for (int m = 0; m < 4; ++m) { const int r = ai * HALF + wr * 64 + m * 16 + fr; float* rowp = O + (size_t)(u.pm * BM + r) * ldc + col0;
#pragma unroll
                for (int bj = 0; bj < 2; ++bj)
#pragma unroll
                    for (int n = 0; n < 2; ++n) *(f32x4*)(rowp + bj * HALF + n * 16) = acc[ai][bj][m][n]; }
    }
};
template <class Epi, class Sched, bool ALIGN_EPI = false, bool SP2 = false>
__device__ __forceinline__ void gemm_phase(PG8_LAS unsigned char* lds, const Gemm g, const Sched& S, const Epi& E) {
    int tid_ = threadIdx.x; asm volatile("" : "+v"(tid_));
    const int tid = tid_, wid = __builtin_amdgcn_readfirstlane(tid >> 6), lane = tid & 63, wr = wid >> 2, wc = wid & 3, fr = lane & 15, fq = lane >> 4;
    const int K = g.K, nt = K / BK;
    unsigned voffA[2], voffB[2];
#pragma unroll
    for (int i = 0; i < 2; ++i) { int R, C; stage_rc(tid * 16 + i * 8192, R, C); const int Rb = Epi::PERM ? ((R & ~31) + perm32(R & 31)) : R;
        voffA[i] = (unsigned)(R * K + C) * 2u; voffB[i] = (unsigned)(Rb * K + C) * 2u; }
    const size_t kstep = (size_t)(BK * 2);
    const size_t hstep = (size_t)HALF * K * 2;
    const size_t tstep = 2 * hstep;
    const unsigned ldsw = (unsigned)wid * 1024u;
    const int aoff = lds_byte(wr * 64 + fr, fq * 8), boff = lds_byte(wc * 32 + fr, fq * 8);
#define PG8_SA(b, h) (((b) * 2 + (h)) * HTB)
#define PG8_SB(b, h) ((4 + (b) * 2 + (h)) * HTB)
#define PG8_STAGE(bufoff, gbase, voff) do { _Pragma("unroll") for (int _i = 0; _i < 2; ++_i) \
        __builtin_amdgcn_global_load_lds((const unsigned*)((const char*)(gbase) + (voff)[_i]), (PG8_LAS unsigned*)(lds + (bufoff) + ldsw + _i * 8192), 16, 0, 0); } while (0)
#define PG8_LDA(dst, b, h) do { _Pragma("unroll") for (int m = 0; m < 4; ++m) _Pragma("unroll") for (int k = 0; k < 2; ++k) dst[m][k] = *(const PG8_LAS bf16x8*)(lds + PG8_SA(b, h) + aoff + m * 2048 + k * 1024); } while (0)
#define PG8_LDB(dst, b, h) do { _Pragma("unroll") for (int n = 0; n < 2; ++n) _Pragma("unroll") for (int k = 0; k < 2; ++k) dst[n][k] = *(const PG8_LAS bf16x8*)(lds + PG8_SB(b, h) + boff + n * 2048 + k * 1024); } while (0)
#define PG8_MMA(ai, bj, At, Bt) do { __builtin_amdgcn_s_setprio(1); _Pragma("unroll") for (int m = 0; m < 4; ++m) _Pragma("unroll") for (int n = 0; n < 2; ++n) _Pragma("unroll") for (int k = 0; k < 2; ++k) \
        acc[ai][bj][m][n] = __builtin_amdgcn_mfma_f32_16x16x32_bf16(Bt[n][k], At[m][k], acc[ai][bj][m][n], 0, 0, 0); __builtin_amdgcn_s_setprio(0); } while (0)
#define PG8_WAIT_V(n) asm volatile("s_waitcnt vmcnt(" #n ")" ::: "memory")
#define PG8_WAIT_L(n) asm volatile("s_waitcnt lgkmcnt(" #n ")" ::: "memory")
#define PG8_BAR __builtin_amdgcn_s_barrier()
#define PG8_SCHED __builtin_amdgcn_sched_barrier(0)
    Unit cur, nxt; int ui = 0;
    if (!S.next(0, cur)) return;
    f32x4 acc[2][2][4][2];
#pragma unroll
    for (int a = 0; a < 2; ++a)
#pragma unroll
        for (int b = 0; b < 2; ++b)
#pragma unroll
            for (int m = 0; m < 4; ++m)
#pragma unroll
                for (int n = 0; n < 2; ++n) acc[a][b][m][n] = (f32x4){0.f, 0.f, 0.f, 0.f};
    bf16x8 At[4][2], B0[2][2], B1[2][2];
    const char* cA = (const char*)g.A + (size_t)cur.pm * tstep; const char* cB = (const char*)g.Bt + (size_t)cur.pn * tstep;
    S.a_ready(cur);
    if constexpr (SP2) {
        PG8_STAGE(PG8_SB(0, 0), cB, voffB); PG8_STAGE(PG8_SB(0, 1), cB + hstep, voffB); PG8_STAGE(PG8_SA(0, 0), cA, voffA); PG8_STAGE(PG8_SA(0, 1), cA + hstep, voffA);
        if (wr == 1) PG8_BAR;
        PG8_WAIT_V(2); PG8_BAR;
        PG8_STAGE(PG8_SB(1, 0), cB + kstep, voffB); PG8_STAGE(PG8_SA(1, 0), cA + kstep, voffA); PG8_STAGE(PG8_SB(1, 1), cB + hstep + kstep, voffB);
        PG8_WAIT_V(6); PG8_BAR;
    } else {
        PG8_STAGE(PG8_SB(0, 0), cB, voffB); PG8_STAGE(PG8_SA(0, 0), cA, voffA); PG8_STAGE(PG8_SB(0, 1), cB + hstep, voffB); PG8_STAGE(PG8_SA(0, 1), cA + hstep, voffA);
        if (wr == 1) PG8_BAR;
        PG8_WAIT_V(4); PG8_BAR;
        PG8_STAGE(PG8_SB(1, 0), cB + kstep, voffB); PG8_STAGE(PG8_SA(1, 0), cA + kstep, voffA); PG8_STAGE(PG8_SB(1, 1), cB + hstep + kstep, voffB);
        PG8_WAIT_V(6); PG8_BAR;
    }
    for (;;) {
        const bool has_next = S.next(ui + 1, nxt);
        const char* nA = has_next ? (const char*)g.A + (size_t)nxt.pm * tstep : cA; const char* nB = has_next ? (const char*)g.Bt + (size_t)nxt.pn * tstep : cB;
        for (int t = 0; t < nt; t += 2) {
            const bool last = (t == nt - 2);
            const char* a1 = cA + (size_t)(t + 1) * kstep;
            const char* a2 = last ? nA : cA + (size_t)(t + 2) * kstep; const char* b2 = last ? nB : cB + (size_t)(t + 2) * kstep;
            const char* a3 = a2 + kstep; const char* b3 = b2 + kstep;
            if (last && has_next) S.a_ready(nxt);
            if constexpr (SP2) {
            PG8_LDB(B0, 0, 0); PG8_LDB(B1, 0, 1); PG8_SCHED; PG8_LDA(At, 0, 0); PG8_STAGE(PG8_SA(1, 1), a1 + hstep, voffA);
            PG8_WAIT_V(8); PG8_WAIT_L(0); PG8_BAR; PG8_MMA(0, 0, At, B0); PG8_MMA(0, 1, At, B1); PG8_BAR; PG8_SCHED;
            PG8_LDA(At, 0, 1); PG8_STAGE(PG8_SB(0, 0), b2, voffB); PG8_STAGE(PG8_SB(0, 1), b2 + hstep, voffB); PG8_STAGE(PG8_SA(0, 0), a2, voffA);
            PG8_WAIT_V(8); PG8_WAIT_L(0); PG8_BAR; PG8_MMA(1, 0, At, B0); PG8_MMA(1, 1, At, B1); PG8_BAR; PG8_SCHED;
            PG8_LDB(B0, 1, 0); PG8_LDB(B1, 1, 1); PG8_SCHED; PG8_LDA(At, 1, 0); PG8_STAGE(PG8_SA(0, 1), a2 + hstep, voffA);
            PG8_WAIT_V(8); PG8_WAIT_L(0); PG8_BAR; PG8_MMA(0, 0, At, B0); PG8_MMA(0, 1, At, B1); PG8_BAR; PG8_SCHED;
            PG8_LDA(At, 1, 1); PG8_STAGE(PG8_SB(1, 0), b3, voffB); PG8_STAGE(PG8_SB(1, 1), b3 + hstep, voffB); PG8_STAGE(PG8_SA(1, 0), a3, voffA);
            PG8_WAIT_V(8); PG8_WAIT_L(0); PG8_BAR; PG8_MMA(1, 0, At, B0); PG8_MMA(1, 1, At, B1); PG8_BAR; PG8_SCHED;
            } else {
            PG8_LDB(B0, 0, 0); PG8_SCHED; PG8_LDA(At, 0, 0); PG8_STAGE(PG8_SA(1, 1), a1 + hstep, voffA);
            PG8_WAIT_L(8); PG8_BAR; PG8_WAIT_L(0); PG8_MMA(0, 0, At, B0); PG8_BAR; PG8_SCHED;
            PG8_LDB(B1, 0, 1); PG8_STAGE(PG8_SB(0, 0), b2, voffB);
            PG8_BAR; PG8_WAIT_L(0); PG8_MMA(0, 1, At, B1); PG8_BAR;
            PG8_LDA(At, 0, 1); PG8_STAGE(PG8_SA(0, 0), a2, voffA);
            PG8_BAR; PG8_WAIT_L(0); PG8_MMA(1, 0, At, B0); PG8_BAR; PG8_SCHED;
            PG8_STAGE(PG8_SB(0, 1), b2 + hstep, voffB);
            PG8_WAIT_V(6); PG8_BAR; PG8_MMA(1, 1, At, B1); PG8_BAR;
            PG8_LDB(B0, 1, 0); PG8_SCHED; PG8_LDA(At, 1, 0); PG8_STAGE(PG8_SA(0, 1), a2 + hstep, voffA);
            PG8_WAIT_L(8); PG8_BAR; PG8_WAIT_L(0); PG8_MMA(0, 0, At, B0); PG8_BAR; PG8_SCHED;
            PG8_LDB(B1, 1, 1); PG8_STAGE(PG8_SB(1, 0), b3, voffB);
            PG8_BAR; PG8_WAIT_L(0); PG8_MMA(0, 1, At, B1); PG8_BAR;
            PG8_LDA(At, 1, 1); PG8_STAGE(PG8_SA(1, 0), a3, voffA);
            PG8_BAR; PG8_WAIT_L(0); PG8_MMA(1, 0, At, B0); PG8_BAR; PG8_SCHED;
            PG8_STAGE(PG8_SB(1, 1), b3 + hstep, voffB);
            PG8_WAIT_V(6); PG8_BAR; PG8_MMA(1, 1, At, B1); PG8_BAR;
            }
        }
        if constexpr (ALIGN_EPI) { if (wr == 0) PG8_BAR; }
        if constexpr (!Epi::AFTER_DRAIN) { E(acc, cur, wr, wc, fr, fq); S.done(cur); }
        if (!has_next) break;
#pragma unroll
        for (int a = 0; a < 2; ++a)
#pragma unroll
            for (int b = 0; b < 2; ++b)
#pragma unroll
                for (int m = 0; m < 4; ++m)
#pragma unroll
                    for (int n = 0; n < 2; ++n) acc[a][b][m][n] = (f32x4){0.f, 0.f, 0.f, 0.f};
        cur = nxt; cA = nA; cB = nB; ++ui;
        if constexpr (ALIGN_EPI) { if (wr == 1) PG8_BAR; }
    }
    PG8_WAIT_V(0);
    if constexpr (!ALIGN_EPI) { if (wr == 0) PG8_BAR; }
    PG8_BAR;
    if constexpr (Epi::AFTER_DRAIN) { E.fused(acc, cur, wr, wc, fr, fq, lds, wid, lane); S.done(cur); }
#undef PG8_SA
#undef PG8_SB
#undef PG8_STAGE
#undef PG8_LDA
#undef PG8_LDB
#undef PG8_MMA
#undef PG8_WAIT_V
#undef PG8_WAIT_L
#undef PG8_BAR
#undef PG8_SCHED
}
}

constexpr int BATCH = 32, SEQ = 2048, DM = 1024, M = BATCH * SEQ;
constexpr int DIN = 4104, NU = 4096;
constexpr int NMEM = 256, MMEM = BATCH * NMEM;
constexpr int UQM = 0, UKM = 512, UVM = 1024, UOM = 1536, UZM = 2048, UQS = 2560, UKS = 2816, UVS = 3072, UZS = 3328, UQC = 3584, UZC = 3840;
constexpr int WIF = 2560;
constexpr float EPS = 1e-6f;
constexpr int YM = 0, YS = 512, YC = 768;

constexpr size_t MiB = 1u << 20;
constexpr size_t WS_CTL = 0, CTL_ZERO_BYTES = 1 * MiB;
constexpr size_t WS_WIN = 2 * MiB;
constexpr size_t WS_WO = 10 * MiB;
constexpr size_t WS_WKV = 12 * MiB;
constexpr size_t WS_G = 14 * MiB;
constexpr size_t WS_MEMN = 16 * MiB;
constexpr size_t WS_KVM = 32 * MiB;
constexpr size_t WS_XN = 64 * MiB;
constexpr size_t WS_Y = 64 * MiB;
constexpr size_t WS_U = 192 * MiB;
constexpr size_t WS_END = 704 * MiB;

typedef unsigned short bf16;
typedef float f32x4 __attribute__((ext_vector_type(4)));
typedef unsigned v4u __attribute__((ext_vector_type(4)));
typedef unsigned v2u __attribute__((ext_vector_type(2)));
#define LAS __attribute__((address_space(3)))

__device__ __forceinline__ unsigned f2bf(float f) { unsigned u = __builtin_bit_cast(unsigned, f); return (u + 0x7fffu + ((u >> 16) & 1u)) >> 16; }
__device__ __forceinline__ unsigned pk2(float lo, float hi) { return f2bf(lo) | (f2bf(hi) << 16); }
__device__ __forceinline__ float bf2f(unsigned h) { return __builtin_bit_cast(float, h << 16); }
__device__ __forceinline__ float bflo(unsigned w) { return __builtin_bit_cast(float, w << 16); }
__device__ __forceinline__ float bfhi(unsigned w) { return __builtin_bit_cast(float, w & 0xffff0000u); }
__device__ __forceinline__ float wave_sum(float v) {
#pragma unroll
    for (int o = 1; o < 64; o <<= 1) v += __shfl_xor(v, o);
    return v;
}
__device__ __forceinline__ float sigmoidf_(float x) { return __builtin_amdgcn_rcpf(1.f + __builtin_amdgcn_exp2f(x * -1.4426950408889634f)); }
__device__ __forceinline__ float siluf_(float x) { return x * __builtin_amdgcn_rcpf(1.f + __builtin_amdgcn_exp2f(x * -1.4426950408889634f)); }

__device__ __forceinline__ void transpose_item(const float* W, int Nsrc, int K, bf16* WT, const float* gk, float* scr, int kb, int n0_dst, int n0_src, int lane) {
    const int k0 = 64 * kb;
#pragma unroll 8
    for (int i = 0; i < 32; ++i) { const int kk = 2 * i + (lane >> 5); const float g = gk ? gk[k0 + kk] : 1.f; scr[kk * 33 + (lane & 31)] = g * W[(size_t)(k0 + kk) * Nsrc + n0_src + (lane & 31)]; }
    __builtin_amdgcn_s_waitcnt(0xC07F); asm volatile("" ::: "memory");
    const int c = lane & 7;
#pragma unroll
    for (int j = 0; j < 4; ++j) { const int n = (lane >> 3) + 8 * j; const float* s = scr + (8 * c) * 33 + n;
        v4u o; o.x = pk2(s[0 * 33], s[1 * 33]); o.y = pk2(s[2 * 33], s[3 * 33]); o.z = pk2(s[4 * 33], s[5 * 33]); o.w = pk2(s[6 * 33], s[7 * 33]);
        *(v4u*)(WT + (size_t)(n0_dst + n) * K + k0 + 8 * c) = o; }
    __builtin_amdgcn_s_waitcnt(0xC07F); asm volatile("" ::: "memory");
}

struct ProArgs {
    const float *x, *mem, *g_pre, *w_in, *i_bias, *f_bias, *g_mem, *w_mem_kv, *w_out;
    bf16 *WIN, *WO, *WKV, *XN, *MEMN; float* G;
};

template <bool GATES>
__device__ __forceinline__ void row_item4(const float* xrow, bf16* orow, float* grow, const float* wif, const float* i_bias, const float* f_bias, int lane) {
    f32x4 v[4][4]; float s[4];
#pragma unroll
    for (int r = 0; r < 4; ++r) { const f32x4* xr = (const f32x4*)(xrow + (size_t)r * DM) + lane;
#pragma unroll
        for (int j = 0; j < 4; ++j) v[r][j] = xr[64 * j]; }
#pragma unroll
    for (int r = 0; r < 4; ++r) { float t = 0.f;
#pragma unroll
        for (int j = 0; j < 4; ++j) t += (v[r][j].x * v[r][j].x + v[r][j].y * v[r][j].y) + (v[r][j].z * v[r][j].z + v[r][j].w * v[r][j].w);
        s[r] = t; }
#pragma unroll
    for (int o = 1; o < 64; o <<= 1) {
#pragma unroll
        for (int r = 0; r < 4; ++r) s[r] += __shfl_xor(s[r], o); }
#pragma unroll
    for (int r = 0; r < 4; ++r) { const float rstd = 1.f / sqrtf(s[r] * (1.f / DM) + EPS);
        unsigned long long* o8 = (unsigned long long*)(orow + (size_t)r * DM) + lane;
#pragma unroll
        for (int j = 0; j < 4; ++j) { v[r][j] = v[r][j] * rstd; o8[64 * j] = (unsigned long long)pk2(v[r][j].x, v[r][j].y) | ((unsigned long long)pk2(v[r][j].z, v[r][j].w) << 32); } }
    if (GATES) {
        float a[4][8];
#pragma unroll
        for (int r = 0; r < 4; ++r)
#pragma unroll
            for (int g = 0; g < 8; ++g) a[r][g] = 0.f;
#pragma unroll
        for (int j = 0; j < 4; ++j)
#pragma unroll
            for (int c = 0; c < 4; ++c) { const int k = 4 * (lane + 64 * j) + c; const f32x4 w0 = *(const f32x4*)(wif + k * 8), w1 = *(const f32x4*)(wif + k * 8 + 4);
#pragma unroll
                for (int r = 0; r < 4; ++r) { const float xv = v[r][j][c];
                    a[r][0] += xv * w0.x; a[r][1] += xv * w0.y; a[r][2] += xv * w0.z; a[r][3] += xv * w0.w; a[r][4] += xv * w1.x; a[r][5] += xv * w1.y; a[r][6] += xv * w1.z; a[r][7] += xv * w1.w; } }
        const bool b0 = lane & 1, b1 = lane & 2, b2 = lane & 4;
        const int gsel = 4 * (lane & 1) + 2 * ((lane >> 1) & 1) + ((lane >> 2) & 1);
#pragma unroll
        for (int r = 0; r < 4; ++r) {
            float b[4], c2[2];
#pragma unroll
            for (int i = 0; i < 4; ++i) { const float send = b0 ? a[r][i] : a[r][i + 4], keep = b0 ? a[r][i + 4] : a[r][i]; b[i] = keep + __shfl_xor(send, 1); }
#pragma unroll
            for (int i = 0; i < 2; ++i) { const float send = b1 ? b[i] : b[i + 2], keep = b1 ? b[i + 2] : b[i]; c2[i] = keep + __shfl_xor(send, 2); }
            const float send = b2 ? c2[0] : c2[1], keep = b2 ? c2[1] : c2[0]; float d = keep + __shfl_xor(send, 4);
            d += __shfl_xor(d, 8); d += __shfl_xor(d, 16); d += __shfl_xor(d, 32);
            if (lane < 8) { if (gsel < 4) grow[r * 8 + gsel] = d + i_bias[gsel];
                            else { const float xx = d + f_bias[gsel - 4]; grow[r * 8 + gsel] = fminf(xx, 0.f) - log1pf(expf(-fabsf(xx))); } }
        }
    }
}

__device__ __forceinline__ void phase_prologue(const ProArgs& a, float* sh, int nblocks, int block) {
    int tid_ = threadIdx.x; asm volatile("" : "+v"(tid_));
    const int tid = tid_, lane = tid & 63, wave = tid >> 6;
    float* scr = sh + wave * 2112; float* wif = sh + 8 * 2112;
    for (int i = tid; i < 8192; i += 512) { const int k = i >> 3, g = i & 7; wif[i] = a.g_pre[k] * a.w_in[(size_t)k * DIN + WIF + g]; }
    __syncthreads();
    const int gw = block * 8 + wave, NGW = nblocks * 8;
    constexpr int I_IN = 16 * 128, I_O = 16 * 32, I_KV = 16 * 16, NIT = I_IN + I_O + I_KV;
    for (int it = gw; it < NIT; it += NGW) {
        int r = it;
        if (r < I_IN) { const int kb = r / 128, nb = r % 128, n0 = 32 * nb; transpose_item(a.w_in, DIN, DM, a.WIN, a.g_pre, scr, kb, n0, n0 + (n0 >= WIF ? 8 : 0), lane); continue; } r -= I_IN;
        if (r < I_O) { const int kb = r / 32, nb = r % 32; transpose_item(a.w_out, DM, DM, a.WO, nullptr, scr, kb, 32 * nb, 32 * nb, lane); continue; } r -= I_O;
        { const int kb = r / 16, nb = r % 16; transpose_item(a.w_mem_kv, 512, DM, a.WKV, a.g_mem, scr, kb, 32 * nb, 32 * nb, lane); }
    }
    for (int m = 4 * gw; m < M; m += 4 * NGW) row_item4<true>(a.x + (size_t)m * DM, a.XN + (size_t)m * DM, a.G + (size_t)m * 8, wif, a.i_bias, a.f_bias, lane);
    for (int m = 4 * gw; m < MMEM; m += 4 * NGW) row_item4<false>(a.mem + (size_t)m * DM, a.MEMN + (size_t)m * DM, nullptr, wif, nullptr, nullptr, lane);
}

__device__ __forceinline__ void final_rows(const float* __restrict__ x, const float* __restrict__ g_post, float* out, int gw, int NGW, int lane) {
    for (int m = gw; m < M; m += NGW) {
        const f32x4* zr = (const f32x4*)(out + (size_t)m * DM) + lane; const f32x4* xr = (const f32x4*)(x + (size_t)m * DM) + lane; const f32x4* gr = (const f32x4*)g_post + lane;
        f32x4 v[4]; float s = 0.f;
#pragma unroll
        for (int j = 0; j < 4; ++j) { v[j] = zr[64 * j]; s += (v[j].x * v[j].x + v[j].y * v[j].y) + (v[j].z * v[j].z + v[j].w * v[j].w); }
        const float rstd = 1.f / sqrtf(wave_sum(s) * (1.f / DM) + EPS);
        f32x4* orow = (f32x4*)(out + (size_t)m * DM) + lane;
#pragma unroll
        for (int j = 0; j < 4; ++j) orow[64 * j] = xr[64 * j] + v[j] * rstd * gr[64 * j];
    }
}

namespace mx {
typedef short bf16x8 __attribute__((ext_vector_type(8)));
typedef short s16x4 __attribute__((ext_vector_type(4)));
typedef float f32x16 __attribute__((ext_vector_type(16)));
typedef unsigned u32x4 __attribute__((ext_vector_type(4)));
typedef LAS unsigned char* ldsp;
#define MFMA32(a, b, c) __builtin_amdgcn_mfma_f32_32x32x16_bf16((a), (b), (c), 0, 0, 0)
__device__ __forceinline__ int crow(int r, int hi) { return (r & 3) + 8 * (r >> 2) + 4 * hi; }
__device__ __forceinline__ s16x4 vtr(ldsp p) { return __builtin_bit_cast(s16x4, __builtin_amdgcn_ds_read_tr16_b64_v4i16((LAS s16x4*)p)); }
__device__ __forceinline__ bf16x8 cat8(s16x4 lo, s16x4 hi) { return __builtin_shufflevector(lo, hi, 0, 1, 2, 3, 4, 5, 6, 7); }
__device__ __forceinline__ unsigned cvtpk(float lo, float hi) { typedef float f2 __attribute__((ext_vector_type(2))); typedef __bf16 b2 __attribute__((ext_vector_type(2))); f2 v = {lo, hi}; b2 b = __builtin_convertvector(v, b2); return __builtin_bit_cast(unsigned, b); }
__device__ __forceinline__ bf16x8 pack8(const f32x16& p, int s) {
    u32x4 w; w.x = cvtpk(p[8 * s], p[8 * s + 1]); w.y = cvtpk(p[8 * s + 2], p[8 * s + 3]); w.z = cvtpk(p[8 * s + 4], p[8 * s + 5]); w.w = cvtpk(p[8 * s + 6], p[8 * s + 7]); return __builtin_bit_cast(bf16x8, w); }
constexpr float LOG2E = 1.4426950408889634f;

__device__ __forceinline__ void stage_kv(const bf16* kbase, const bf16* vbase, size_t pitch, ldsp kslot, ldsp vslot, int wid, int lane) {
    const u32x4 kx = *(const u32x4*)(kbase + (size_t)lane * pitch + wid * 8);
    const u32x4 vx = *(const u32x4*)(vbase + (size_t)(16 * (wid & 3) + (lane >> 2)) * pitch + (wid >> 2) * 32 + (lane & 3) * 8);
    *(LAS u32x4*)(kslot + wid * 1024 + lane * 16) = kx;
    *(LAS u32x4*)(vslot + wid * 1024 + lane * 16) = vx;
}
__device__ __forceinline__ void qkt(f32x16& p0, f32x16& p1, ldsp kslot, const bf16x8 (&qr)[4], int r32, int hi) {
    const ldsp kb = kslot + hi * 1024 + r32 * 16;
    f32x16 z;
#pragma unroll
    for (int i = 0; i < 16; ++i) z[i] = 0.f;
    p0 = z; p1 = z;
#pragma unroll
    for (int d0 = 0; d0 < 4; ++d0) { const bf16x8 b0 = *(const LAS bf16x8*)(kb + d0 * 2048), b1 = *(const LAS bf16x8*)(kb + d0 * 2048 + 512);
        p0 = MFMA32(b0, qr[d0], p0); p1 = MFMA32(b1, qr[d0], p1); }
}
__device__ __forceinline__ void qkt_half(f32x16& p, ldsp kslot, const bf16x8 (&qr)[4], int half, int r32, int hi) {
    const ldsp kb = kslot + hi * 1024 + r32 * 16 + half * 512;
#pragma unroll
    for (int i = 0; i < 16; ++i) p[i] = 0.f;
#pragma unroll
    for (int d0 = 0; d0 < 4; ++d0) { const bf16x8 b0 = *(const LAS bf16x8*)(kb + d0 * 2048); p = MFMA32(b0, qr[d0], p); }
}
__device__ __forceinline__ void pv64(f32x16 (&o)[2], ldsp vslot, const bf16x8 (&pa)[4], int lane, int hi) {
    const ldsp vb = vslot + ((lane >> 4) & 1) * 32 + (lane & 3) * 8 + (4 * hi + ((lane & 15) >> 2)) * 64;
#pragma unroll
    for (int d0 = 0; d0 < 2; ++d0)
#pragma unroll
        for (int ks = 0; ks < 4; ++ks) { const s16x4 lo = vtr(vb + d0 * 4096 + ks * 1024), h4 = vtr(vb + d0 * 4096 + ks * 1024 + 512); o[d0] = MFMA32(pa[ks], cat8(lo, h4), o[d0]); }
}
template <bool MASK> __device__ __forceinline__ float sb_half(f32x16& y, float base, int s0, int t, int hi) {
    float sp[16];
#pragma unroll
    for (int r = 0; r < 16; ++r) { const float v = y[r]; float s = fmaxf(v, 0.f) + __builtin_amdgcn_logf(1.f + __builtin_amdgcn_exp2f(-fabsf(v)));
        if (MASK) { if (!(s0 + crow(r, hi) < t)) s = 0.f; } sp[r] = s; }
    float bs[4], ot[4];
#pragma unroll
    for (int g = 0; g < 4; ++g) { bs[g] = (sp[4 * g] + sp[4 * g + 1]) + (sp[4 * g + 2] + sp[4 * g + 3]); ot[g] = __shfl_xor(bs[g], 32); }
    float so[4]; so[3] = 0.f; so[2] = bs[3] + ot[3]; so[1] = so[2] + (bs[2] + ot[2]); so[0] = so[1] + (bs[1] + ot[1]);
    const float total = so[0] + (bs[0] + ot[0]);
#pragma unroll
    for (int g = 0; g < 4; ++g) { const float e = base + so[g] + (hi == 0 ? ot[g] : 0.f);
        const float c3 = e + sp[4 * g + 3], c2 = c3 + sp[4 * g + 2], c1 = c2 + sp[4 * g + 1], c0 = c1 + sp[4 * g];
        float a0 = __builtin_amdgcn_exp2f(y[4 * g] - c0), a1 = __builtin_amdgcn_exp2f(y[4 * g + 1] - c1), a2 = __builtin_amdgcn_exp2f(y[4 * g + 2] - c2), a3 = __builtin_amdgcn_exp2f(y[4 * g + 3] - c3);
        if (MASK) { if (!(s0 + crow(4 * g, hi) < t)) a0 = 0.f; if (!(s0 + crow(4 * g + 1, hi) < t)) a1 = 0.f; if (!(s0 + crow(4 * g + 2, hi) < t)) a2 = 0.f; if (!(s0 + crow(4 * g + 3, hi) < t)) a3 = 0.f; }
        y[4 * g] = a0; y[4 * g + 1] = a1; y[4 * g + 2] = a2; y[4 * g + 3] = a3; }
    return total;
}
constexpr int ATT_K = 0, ATT_V = 32768, ATT_STG = 65536, ATT_STG_W = 8320, ATT_FLAG = ATT_STG + 8 * ATT_STG_W;
constexpr float SB_THR = 127.f;

__device__ __forceinline__ void attn_epilogue(const f32x16 (&o)[2], LAS float* stg, float rs, const float* __restrict__ gain, const bf16* __restrict__ zrow, bf16* __restrict__ yrow, int r32, int hi) {
#pragma unroll
    for (int d0 = 0; d0 < 2; ++d0)
#pragma unroll
        for (int r = 0; r < 16; ++r) stg[crow(r, hi) * 65 + d0 * 32 + r32] = o[d0][r];
    __builtin_amdgcn_s_waitcnt(0xC07F); asm volatile("" ::: "memory");
    float v[32]; float ss = 0.f;
#pragma unroll
    for (int i = 0; i < 32; ++i) { v[i] = stg[r32 * 65 + hi * 32 + i] * rs; ss += v[i] * v[i]; }
    ss += __shfl_xor(ss, 32);
    const float rn = __builtin_amdgcn_rsqf(ss * (1.f / 64.f) + EPS);
#pragma unroll
    for (int c = 0; c < 4; ++c) { const u32x4 zw = *(const u32x4*)(zrow + hi * 32 + c * 8); const f32x4 g0 = *(const f32x4*)(gain + hi * 32 + c * 8), g1 = *(const f32x4*)(gain + hi * 32 + c * 8 + 4);
        u32x4 ow;
        ow.x = cvtpk(v[8 * c] * rn * g0.x * siluf_(bflo(zw.x)), v[8 * c + 1] * rn * g0.y * siluf_(bfhi(zw.x)));
        ow.y = cvtpk(v[8 * c + 2] * rn * g0.z * siluf_(bflo(zw.y)), v[8 * c + 3] * rn * g0.w * siluf_(bfhi(zw.y)));
        ow.z = cvtpk(v[8 * c + 4] * rn * g1.x * siluf_(bflo(zw.z)), v[8 * c + 5] * rn * g1.y * siluf_(bfhi(zw.z)));
        ow.w = cvtpk(v[8 * c + 6] * rn * g1.z * siluf_(bflo(zw.w)), v[8 * c + 7] * rn * g1.w * siluf_(bfhi(zw.w)));
        *(u32x4*)(yrow + hi * 32 + c * 8) = ow; }
}

__device__ __forceinline__ void sb_unit(int b, int h, int qb, const bf16* __restrict__ U, const float* __restrict__ g_head, bf16* __restrict__ Y, ldsp lds) {
    int tid_ = threadIdx.x; asm volatile("" : "+v"(tid_));
    const int tid = tid_, lane = tid & 63, r32 = lane & 31, hi = lane >> 5, wid = __builtin_amdgcn_readfirstlane(tid >> 6);
    const size_t row0 = (size_t)b * SEQ; const int q0 = qb * 256, qw = q0 + 32 * wid, t = qw + r32;
    LAS unsigned* flag = (LAS unsigned*)(lds + ATT_FLAG);
    const bf16* Kg = U + row0 * NU + UKS + h * 64; const bf16* Vg = U + row0 * NU + UVS + h * 64;
    bf16x8 qr[4];
#pragma unroll
    for (int d0 = 0; d0 < 4; ++d0) qr[d0] = *(const bf16x8*)(U + (row0 + t) * NU + UQS + h * 64 + d0 * 16 + hi * 8);
    f32x16 o[2];
#pragma unroll
    for (int i = 0; i < 16; ++i) { o[0][i] = 0.f; o[1][i] = 0.f; }
    float R = 0.f; bool done = false;
    const int my_jt = qw >> 6;
    if (tid < 8) flag[tid] = 0u;
#pragma unroll 1
    for (int jt = 4 * qb + 3; jt >= 0; --jt) {
        __syncthreads();
        { unsigned all = 1u;
#pragma unroll
          for (int i = 0; i < 8; ++i) all &= flag[i];
          if (all) break; }
        stage_kv(Kg + (size_t)jt * 64 * NU, Vg + (size_t)jt * 64 * NU, NU, lds + ATT_K, lds + ATT_V, wid, lane);
        __syncthreads();
        if (jt <= my_jt && !done) {
            bf16x8 pa[4]; f32x16 p; float t1, t0;
            qkt_half(p, lds + ATT_K, qr, 1, r32, hi);
#pragma unroll
            for (int i = 0; i < 16; ++i) p[i] *= 0.125f * LOG2E;
            if (jt == my_jt) t1 = sb_half<true>(p, R, jt * 64 + 32, t, hi); else t1 = sb_half<false>(p, R, jt * 64 + 32, t, hi);
            pa[2] = pack8(p, 0); pa[3] = pack8(p, 1);
            qkt_half(p, lds + ATT_K, qr, 0, r32, hi);
#pragma unroll
            for (int i = 0; i < 16; ++i) p[i] *= 0.125f * LOG2E;
            if (jt == my_jt) t0 = sb_half<true>(p, R + t1, jt * 64, t, hi); else t0 = sb_half<false>(p, R + t1, jt * 64, t, hi);
            pa[0] = pack8(p, 0); pa[1] = pack8(p, 1);
            R += t1 + t0;
            pv64(o, lds + ATT_V, pa, lane, hi);
            done = __all(R >= SB_THR) != 0;
        }
        if (lane == 0 && done) flag[wid] = 1u;
    }
    attn_epilogue(o, (LAS float*)(lds + ATT_STG + wid * ATT_STG_W), 1.f, g_head + h * 64, U + (row0 + t) * NU + UZS + h * 64, Y + (row0 + t) * DM + YS + h * 64, r32, hi);
    __syncthreads();
}

__device__ __forceinline__ void mem_unit(int b, int h, int qb, const bf16* __restrict__ U, const bf16* __restrict__ KVM, const float* __restrict__ g_head, bf16* __restrict__ Y, ldsp lds) {
    int tid_ = threadIdx.x; asm volatile("" : "+v"(tid_));
    const int tid = tid_, lane = tid & 63, r32 = lane & 31, hi = lane >> 5, wid = __builtin_amdgcn_readfirstlane(tid >> 6);
    const size_t row0 = (size_t)b * SEQ; const int t = qb * 256 + 32 * wid + r32;
    const bf16* Kg = KVM + (size_t)b * NMEM * 512 + h * 64; const bf16* Vg = Kg + 256;
#pragma unroll
    for (int jt = 0; jt < 4; ++jt) stage_kv(Kg + (size_t)jt * 64 * 512, Vg + (size_t)jt * 64 * 512, 512, lds + ATT_K + jt * 8192, lds + ATT_V + jt * 8192, wid, lane);
    bf16x8 qr[4];
#pragma unroll
    for (int d0 = 0; d0 < 4; ++d0) qr[d0] = *(const bf16x8*)(U + (row0 + t) * NU + UQC + h * 64 + d0 * 16 + hi * 8);
    __syncthreads();
    float mx_ = -3.0e38f;
#pragma unroll 1
    for (int jt = 0; jt < 4; ++jt) { f32x16 p0, p1; qkt(p0, p1, lds + ATT_K + jt * 8192, qr, r32, hi);
#pragma unroll
        for (int i = 0; i < 16; ++i) mx_ = fmaxf(mx_, fmaxf(p0[i], p1[i])); }
    mx_ = fmaxf(mx_, __shfl_xor(mx_, 32));
    const float mc = mx_ * (0.125f * LOG2E);
    f32x16 o[2];
#pragma unroll
    for (int i = 0; i < 16; ++i) { o[0][i] = 0.f; o[1][i] = 0.f; }
    float l = 0.f;
#pragma unroll 1
    for (int jt = 0; jt < 4; ++jt) { f32x16 p0, p1; qkt(p0, p1, lds + ATT_K + jt * 8192, qr, r32, hi);
#pragma unroll
        for (int i = 0; i < 16; ++i) { p0[i] = __builtin_amdgcn_exp2f(p0[i] * (0.125f * LOG2E) - mc); p1[i] = __builtin_amdgcn_exp2f(p1[i] * (0.125f * LOG2E) - mc); l += p0[i] + p1[i]; }
        bf16x8 pa[4]; pa[0] = pack8(p0, 0); pa[1] = pack8(p0, 1); pa[2] = pack8(p1, 0); pa[3] = pack8(p1, 1);
        pv64(o, lds + ATT_V + jt * 8192, pa, lane, hi); }
    l += __shfl_xor(l, 32);
    attn_epilogue(o, (LAS float*)(lds + ATT_STG + wid * ATT_STG_W), __builtin_amdgcn_rcpf(l), g_head + h * 64, U + (row0 + t) * NU + UZC + h * 64, Y + (row0 + t) * DM + YC + h * 64, r32, hi);
    __syncthreads();
}
}

namespace ml {
using namespace mx;
constexpr int QK_CS = 1040;
constexpr int V_BS = 4160;
constexpr int ML_Q = 0, ML_K = 16640, ML_V = 33280, ML_VW = 49920, ML_CT = 66560, ML_H = 99328, H_LD = 132, ML_TAB = ML_H + 64 * H_LD * 4;
constexpr int T_A2 = 0, T_N = 64, T_CW = 192, T_SCR = T_CW + 1280, T_NS = T_SCR + 512, T_END = T_NS + 1024;
static_assert(ML_TAB + T_END * 4 <= 147456 - 64, "mLSTM LDS map");


__device__ __forceinline__ float dpp_shr(float idn, float v, int n) {
    const int o = __builtin_bit_cast(int, idn), x = __builtin_bit_cast(int, v); int r;
    switch (n) { case 1: r = __builtin_amdgcn_update_dpp(o, x, 0x111, 0xf, 0xf, false); break; case 2: r = __builtin_amdgcn_update_dpp(o, x, 0x112, 0xf, 0xf, false); break;
                 case 4: r = __builtin_amdgcn_update_dpp(o, x, 0x114, 0xf, 0xf, false); break; default: r = __builtin_amdgcn_update_dpp(o, x, 0x118, 0xf, 0xf, false); break; }
    return __builtin_bit_cast(float, r);
}
__device__ __forceinline__ float rdlane(float v, int l) { return __builtin_bit_cast(float, __builtin_amdgcn_readlane(__builtin_bit_cast(int, v), l)); }
__device__ __forceinline__ float scan_add64(float v, int lane) {
    v += dpp_shr(0.f, v, 1); v += dpp_shr(0.f, v, 2); v += dpp_shr(0.f, v, 4); v += dpp_shr(0.f, v, 8);
    const float r0 = rdlane(v, 15), r1 = rdlane(v, 31), r2 = rdlane(v, 47);
    return v + (lane >= 48 ? (r0 + r1) + r2 : lane >= 32 ? r0 + r1 : lane >= 16 ? r0 : 0.f);
}
__device__ __forceinline__ float scan_max64(float v, int lane) {
    const float NI = -3.0e38f;
    v = fmaxf(v, dpp_shr(NI, v, 1)); v = fmaxf(v, dpp_shr(NI, v, 2)); v = fmaxf(v, dpp_shr(NI, v, 4)); v = fmaxf(v, dpp_shr(NI, v, 8));
    const float r0 = rdlane(v, 15), r1 = rdlane(v, 31), r2 = rdlane(v, 47);
    return fmaxf(v, lane >= 48 ? fmaxf(fmaxf(r0, r1), r2) : lane >= 32 ? fmaxf(r0, r1) : lane >= 16 ? r0 : NI);
}

__device__ __forceinline__ void mlstm_unit(int b, int h, const bf16* __restrict__ U, const float* __restrict__ G, const float* __restrict__ conv_w, const float* __restrict__ conv_b,
                                           const float* __restrict__ g_head, bf16* __restrict__ Y, ldsp lds) {
    int tid_ = threadIdx.x; asm volatile("" : "+v"(tid_));
    const int tid = tid_, lane = tid & 63, r32 = lane & 31, hi = lane >> 5, wid = __builtin_amdgcn_readfirstlane(tid >> 6);
    const size_t row0 = (size_t)b * SEQ;
    LAS float* tab = (LAS float*)(lds + ML_TAB);
    LAS float* Hst = (LAS float*)(lds + ML_H);
    for (int i = tid; i < 2048; i += 512) *(LAS u32x4*)(lds + ML_CT + i * 16) = (u32x4){0u, 0u, 0u, 0u};
    if (tid < 128) tab[T_N + tid] = 0.f;
    for (int i = tid; i < 1280; i += 512) { float v;
        if (i < 512) v = conv_w[(i >> 7) * 1024 + h * 128 + (i & 127)];
        else if (i < 1024) v = conv_w[((i - 512) >> 7) * 1024 + 512 + h * 128 + (i & 127)];
        else if (i < 1152) v = conv_b[h * 128 + (i & 127)]; else v = conv_b[512 + h * 128 + (i & 127)];
        tab[T_CW + i] = v; }
    f32x16 Cacc[2];
#pragma unroll
    for (int i = 0; i < 16; ++i) { Cacc[0][i] = 0.f; Cacc[1][i] = 0.f; }
    float m_prev = 0.f;
    const int qblk = wid & 1, eq = wid >> 1, dblk = wid & 3, epair = wid >> 2;
    const int ch = tid & 15, rg = tid >> 4;
    const int which = wid >> 2, rg4 = (tid >> 4) & 15;
    u32x4 raw[7], ozr[4]; float lf_n, ip_n;
#define ML_PREFETCH(cn) do { const int t0n_ = (cn) * 64; \
        const bf16* src_ = U + (row0 + t0n_ + 4 * rg4) * (size_t)NU + h * 128 + 8 * ch + (which ? UKM : UQM); \
        _Pragma("unroll") for (int i_ = 0; i_ < 7; ++i_) { raw[i_] = (u32x4){0u, 0u, 0u, 0u}; if (t0n_ + 4 * rg4 - 3 + i_ >= 0) raw[i_] = *(const u32x4*)(src_ + (ptrdiff_t)(i_ - 3) * NU); } \
        lf_n = G[(row0 + t0n_ + lane) * 8 + 4 + h]; ip_n = G[(row0 + t0n_ + lane) * 8 + h]; } while (0)
    ML_PREFETCH(0);
    __syncthreads();
#pragma unroll 1
    for (int c = 0; c < SEQ / 64; ++c) {
        const int t0 = c * 64;
        float bcum, a_, Mt, wend, iw, em, decay, m_new;
        u32x4 vraw[2]; { const bf16* vs_ = U + (row0 + t0 + 2 * rg) * (size_t)NU + h * 128 + 8 * ch + UVM; vraw[0] = *(const u32x4*)vs_; vraw[1] = *(const u32x4*)(vs_ + NU); }
        { const float lf = lf_n, ip = ip_n;
          bcum = scan_add64(lf, lane);
          a_ = ip - bcum; const float pm = scan_max64(a_, lane);
          Mt = fmaxf(m_prev, pm); const float Mlast = rdlane(Mt, 63), blast = rdlane(bcum, 63);
          wend = __builtin_amdgcn_exp2f((a_ - Mlast) * LOG2E); iw = __builtin_amdgcn_exp2f((m_prev - Mt) * LOG2E); em = __builtin_amdgcn_exp2f((-bcum - Mt) * LOG2E); decay = __builtin_amdgcn_exp2f((m_prev - Mlast) * LOG2E); m_new = blast + Mlast;
          if (wid == 0) tab[T_A2 + lane] = a_ * LOG2E; }
        { float x[7][8];
#pragma unroll
          for (int i = 0; i < 7; ++i) { const u32x4 w = raw[i];
              x[i][0] = bflo(w.x); x[i][1] = bfhi(w.x); x[i][2] = bflo(w.y); x[i][3] = bfhi(w.y); x[i][4] = bflo(w.z); x[i][5] = bfhi(w.z); x[i][6] = bflo(w.w); x[i][7] = bfhi(w.w); }
          const LAS float* cw = tab + T_CW + which * 512 + 8 * ch; const LAS float* cb = tab + T_CW + 1024 + which * 128 + 8 * ch;
          const float sc = which ? 0.08838834764831845f : 1.f;
          const ldsp dst = lds + (which ? ML_K : ML_Q) + ch * QK_CS + (4 * rg4) * 16;
#pragma unroll
          for (int r = 0; r < 4; ++r) { float o[8];
#pragma unroll
              for (int d = 0; d < 8; ++d) o[d] = cb[d];
#pragma unroll
              for (int j = 0; j < 4; ++j)
#pragma unroll
                  for (int d = 0; d < 8; ++d) o[d] += cw[j * 128 + d] * x[r + j][d];
#pragma unroll
              for (int d = 0; d < 8; ++d) o[d] = siluf_(o[d]) * sc;
              u32x4 w; w.x = cvtpk(o[0], o[1]); w.y = cvtpk(o[2], o[3]); w.z = cvtpk(o[4], o[5]); w.w = cvtpk(o[6], o[7]);
              *(LAS u32x4*)(dst + r * 16) = w; }
          const int rA = 2 * rg;
          const float we0 = __shfl(wend, rA), we1 = __shfl(wend, rA + 1);
          const u32x4 v0 = vraw[0], v1 = vraw[1];
          const ldsp vd = lds + ML_V + (ch >> 2) * V_BS + rA * 64 + (ch & 3) * 16; const ldsp vwd = vd + (ML_VW - ML_V);
          *(LAS u32x4*)vd = v0; *(LAS u32x4*)(vd + 64) = v1;
          u32x4 s0, s1;
          s0.x = cvtpk(bflo(v0.x) * we0, bfhi(v0.x) * we0); s0.y = cvtpk(bflo(v0.y) * we0, bfhi(v0.y) * we0); s0.z = cvtpk(bflo(v0.z) * we0, bfhi(v0.z) * we0); s0.w = cvtpk(bflo(v0.w) * we0, bfhi(v0.w) * we0);
          s1.x = cvtpk(bflo(v1.x) * we1, bfhi(v1.x) * we1); s1.y = cvtpk(bflo(v1.y) * we1, bfhi(v1.y) * we1); s1.z = cvtpk(bflo(v1.z) * we1, bfhi(v1.z) * we1); s1.w = cvtpk(bflo(v1.w) * we1, bfhi(v1.w) * we1);
          *(LAS u32x4*)vwd = s0; *(LAS u32x4*)(vwd + 64) = s1; }
        __syncthreads();
        if (c + 1 < SEQ / 64) ML_PREFETCH(c + 1);
        {
            const int tq = 32 * qblk + r32;
            const float M2 = __shfl(Mt, tq) * LOG2E, iw_q = __shfl(iw, tq), em_q = __shfl(em, tq);
            bf16x8 qf[8];
#pragma unroll
            for (int ks = 0; ks < 8; ++ks) qf[ks] = *(const LAS bf16x8*)(lds + ML_Q + (2 * ks + hi) * QK_CS + tq * 16);
            f32x16 osv, oqc;
#pragma unroll
            for (int i = 0; i < 16; ++i) { osv[i] = 0.f; oqc[i] = 0.f; }
            float den = 0.f;
            const ldsp vb = lds + ML_V + eq * V_BS + ((lane >> 4) & 1) * 32 + (lane & 3) * 8 + (4 * hi + ((lane & 15) >> 2)) * 64;
#pragma unroll
            for (int kt = 0; kt < 2; ++kt) {
                if (kt <= qblk) {
                    f32x16 p;
#pragma unroll
                    for (int i = 0; i < 16; ++i) p[i] = 0.f;
#pragma unroll
                    for (int ks = 0; ks < 8; ++ks) { const bf16x8 kf = *(const LAS bf16x8*)(lds + ML_K + (2 * ks + hi) * QK_CS + (32 * kt + r32) * 16); p = MFMA32(kf, qf[ks], p); }
#pragma unroll
                    for (int g = 0; g < 4; ++g) { const f32x4 a4 = *(const LAS f32x4*)(tab + T_A2 + 32 * kt + 8 * g + 4 * hi);
#pragma unroll
                        for (int j = 0; j < 4; ++j) { float w = __builtin_amdgcn_exp2f(a4[j] - M2); if (kt == qblk) { if (8 * g + 4 * hi + j > r32) w = 0.f; }
                            const float v = p[4 * g + j] * w; p[4 * g + j] = v; den += v; } }
                    const bf16x8 pa0 = pack8(p, 0), pa1 = pack8(p, 1);
                    { const s16x4 lo = vtr(vb + (2 * kt) * 1024), h4 = vtr(vb + (2 * kt) * 1024 + 512); osv = MFMA32(pa0, cat8(lo, h4), osv); }
                    { const s16x4 lo = vtr(vb + (2 * kt + 1) * 1024), h4 = vtr(vb + (2 * kt + 1) * 1024 + 512); osv = MFMA32(pa1, cat8(lo, h4), osv); }
                }
            }
            den += __shfl_xor(den, 32);
            float qn = 0.f;
#pragma unroll
            for (int ks = 0; ks < 8; ++ks) { const bf16x8 kf = *(const LAS bf16x8*)(lds + ML_CT + (2 * ks + hi) * 2048 + (32 * eq + r32) * 16); oqc = MFMA32(qf[ks], kf, oqc);
                const f32x4 n0 = *(const LAS f32x4*)(tab + T_N + 16 * ks + 8 * hi), n1 = *(const LAS f32x4*)(tab + T_N + 16 * ks + 8 * hi + 4);
                const u32x4 qw = __builtin_bit_cast(u32x4, qf[ks]);
                qn += bflo(qw.x) * n0.x + bfhi(qw.x) * n0.y + bflo(qw.y) * n0.z + bfhi(qw.y) * n0.w + bflo(qw.z) * n1.x + bfhi(qw.z) * n1.y + bflo(qw.w) * n1.z + bfhi(qw.w) * n1.w; }
            qn += __shfl_xor(qn, 32);
            const float dinv = __builtin_amdgcn_rcpf(fmaxf(fabsf(den + iw_q * qn), em_q));
            LAS float* scr = tab + T_SCR + wid * 64;
            if (hi == 0) { scr[r32] = iw_q; scr[32 + r32] = dinv; }
            __builtin_amdgcn_s_waitcnt(0xC07F); asm volatile("" ::: "memory");
#pragma unroll
            for (int g = 0; g < 4; ++g) { const f32x4 i4 = *(const LAS f32x4*)(scr + 8 * g + 4 * hi), d4 = *(const LAS f32x4*)(scr + 32 + 8 * g + 4 * hi);
#pragma unroll
                for (int j = 0; j < 4; ++j) Hst[(32 * qblk + 8 * g + 4 * hi + j) * H_LD + 32 * eq + r32] = (osv[4 * g + j] + i4[j] * oqc[4 * g + j]) * d4[j]; }
        }
        { const int tg_ = tid >> 3, eg_ = 16 * (tid & 7); const size_t rowg_ = row0 + t0 + tg_;
          const bf16* op_ = U + rowg_ * NU + UOM + h * 128 + eg_; const bf16* zp_ = U + rowg_ * NU + UZM + h * 128 + eg_;
          ozr[0] = *(const u32x4*)op_; ozr[1] = *(const u32x4*)(op_ + 8); ozr[2] = *(const u32x4*)zp_; ozr[3] = *(const u32x4*)(zp_ + 8); }
        {
            const int blk = (lane >> 4) & 1, q4 = (lane & 15) >> 2, p4 = lane & 3;
            const ldsp ka = lds + ML_K + (4 * dblk + 2 * blk + (p4 >> 1)) * QK_CS + (4 * hi + q4) * 16 + (p4 & 1) * 8;
            const ldsp vwb = lds + ML_VW + (2 * epair) * V_BS + blk * 32 + p4 * 8 + (4 * hi + q4) * 64;
#pragma unroll
            for (int i = 0; i < 16; ++i) { Cacc[0][i] *= decay; Cacc[1][i] *= decay; }
#pragma unroll
            for (int ks = 0; ks < 4; ++ks) { const bf16x8 af = cat8(vtr(ka + ks * 256), vtr(ka + ks * 256 + 128));
                const bf16x8 b0 = cat8(vtr(vwb + ks * 1024), vtr(vwb + ks * 1024 + 512)), b1 = cat8(vtr(vwb + V_BS + ks * 1024), vtr(vwb + V_BS + ks * 1024 + 512));
                Cacc[0] = MFMA32(af, b0, Cacc[0]); Cacc[1] = MFMA32(af, b1, Cacc[1]); }
            const float we0 = __shfl(wend, 2 * rg), we1 = __shfl(wend, 2 * rg + 1);
            const u32x4 k0 = *(const LAS u32x4*)(lds + ML_K + ch * QK_CS + (2 * rg) * 16), k1 = *(const LAS u32x4*)(lds + ML_K + ch * QK_CS + (2 * rg + 1) * 16);
            float np_[8];
            np_[0] = bflo(k0.x) * we0 + bflo(k1.x) * we1; np_[1] = bfhi(k0.x) * we0 + bfhi(k1.x) * we1; np_[2] = bflo(k0.y) * we0 + bflo(k1.y) * we1; np_[3] = bfhi(k0.y) * we0 + bfhi(k1.y) * we1;
            np_[4] = bflo(k0.z) * we0 + bflo(k1.z) * we1; np_[5] = bfhi(k0.z) * we0 + bfhi(k1.z) * we1; np_[6] = bflo(k0.w) * we0 + bflo(k1.w) * we1; np_[7] = bfhi(k0.w) * we0 + bfhi(k1.w) * we1;
#pragma unroll
            for (int d = 0; d < 8; ++d) { np_[d] += __shfl_xor(np_[d], 16); np_[d] += __shfl_xor(np_[d], 32); }
            if (lane < 16) {
#pragma unroll
                for (int d = 0; d < 8; ++d) tab[T_NS + wid * 128 + 8 * lane + d] = np_[d]; }
        }
        __syncthreads();
        {
#pragma unroll
            for (int i = 0; i < 2; ++i)
#pragma unroll
                for (int g = 0; g < 4; ++g) { typedef unsigned u32x2 __attribute__((ext_vector_type(2))); u32x2 w; w.x = cvtpk(Cacc[i][4 * g], Cacc[i][4 * g + 1]); w.y = cvtpk(Cacc[i][4 * g + 2], Cacc[i][4 * g + 3]);
                    *(LAS u32x2*)(lds + ML_CT + (4 * dblk + g) * 2048 + (32 * (2 * epair + i) + r32) * 16 + 8 * hi) = w; }
            if (tid < 128) { float s = decay * tab[T_N + tid];
#pragma unroll
                for (int w = 0; w < 8; ++w) s += tab[T_NS + w * 128 + tid];
                tab[T_N + tid] = s; }
            const int t = tid >> 3, e0 = 16 * (tid & 7);
            float hv[16]; float ss = 0.f;
#pragma unroll
            for (int i = 0; i < 4; ++i) { const f32x4 x = *(const LAS f32x4*)(Hst + t * H_LD + e0 + 4 * i); hv[4 * i] = x.x; hv[4 * i + 1] = x.y; hv[4 * i + 2] = x.z; hv[4 * i + 3] = x.w; ss += (x.x * x.x + x.y * x.y) + (x.z * x.z + x.w * x.w); }
            ss += __shfl_xor(ss, 1); ss += __shfl_xor(ss, 2); ss += __shfl_xor(ss, 4);
            const float rn = __builtin_amdgcn_rsqf(ss * (1.f / 128.f) + EPS);
            const size_t row = row0 + t0 + t;
            const float* gp = g_head + h * 128 + e0;
            bf16* yp = Y + row * DM + YM + h * 128 + e0;
#pragma unroll
            for (int c2 = 0; c2 < 2; ++c2) { const u32x4 ow = ozr[c2], zw = ozr[2 + c2]; const f32x4 g0 = *(const f32x4*)(gp + 8 * c2), g1 = *(const f32x4*)(gp + 8 * c2 + 4);
                u32x4 yw;
                yw.x = cvtpk(sigmoidf_(bflo(ow.x)) * hv[8 * c2] * rn * g0.x * siluf_(bflo(zw.x)), sigmoidf_(bfhi(ow.x)) * hv[8 * c2 + 1] * rn * g0.y * siluf_(bfhi(zw.x)));
                yw.y = cvtpk(sigmoidf_(bflo(ow.y)) * hv[8 * c2 + 2] * rn * g0.z * siluf_(bflo(zw.y)), sigmoidf_(bfhi(ow.y)) * hv[8 * c2 + 3] * rn * g0.w * siluf_(bfhi(zw.y)));
                yw.z = cvtpk(sigmoidf_(bflo(ow.z)) * hv[8 * c2 + 4] * rn * g1.x * siluf_(bflo(zw.z)), sigmoidf_(bfhi(ow.z)) * hv[8 * c2 + 5] * rn * g1.y * siluf_(bfhi(zw.z)));
                yw.w = cvtpk(sigmoidf_(bflo(ow.w)) * hv[8 * c2 + 6] * rn * g1.z * siluf_(bflo(zw.w)), sigmoidf_(bfhi(ow.w)) * hv[8 * c2 + 7] * rn * g1.w * siluf_(bfhi(zw.w)));
                *(u32x4*)(yp + 8 * c2) = yw; }
        }
        m_prev = m_new;
    }
#undef ML_PREFETCH
    __syncthreads();
}
}
#define XB_TMO      128
#define XB_XCNT(j)  (256  + 64 * (j))
#define XB_XSUB(j)  (1280 + 64 * (j))
#define XB_XGEN(j)  (2304 + 64 * (j))
#define XB_TOP      3328
#define XB_TOPGEN   3392
#define XCD_BAR_WORDS 3456
#define XB_SPIN_CAP (1u << 18)

__device__ __forceinline__ unsigned xb_ld(unsigned* p)              { return __hip_atomic_load(p, __ATOMIC_RELAXED, __HIP_MEMORY_SCOPE_AGENT); }
__device__ __forceinline__ unsigned xb_add(unsigned* p, unsigned v) { return __hip_atomic_fetch_add(p, v, __ATOMIC_RELAXED, __HIP_MEMORY_SCOPE_AGENT); }
__device__ __forceinline__ unsigned xb_xcc_id() { return (unsigned)__builtin_amdgcn_s_getreg((3 << 11) | 20) & 0xFu; }
#define XB_SPIN(cond, bar) do { unsigned _sp = 0; while (cond) { __builtin_amdgcn_s_sleep(1); \
    if ((++_sp & 255u) == 0u) { if (xb_ld(&(bar)[XB_TMO])) break; if (_sp > XB_SPIN_CAP) { atomicAdd(&(bar)[XB_TMO], 1u); break; } } } } while (0)

struct XcdBarrier {
    unsigned* bar; unsigned x;
    volatile LAS unsigned* st;
};

__device__ __forceinline__ XcdBarrier xcd_barrier_post(unsigned* bar, volatile LAS unsigned* st) {
    XcdBarrier b; b.bar = bar; b.x = xb_xcc_id(); b.st = st;
    if (threadIdx.x == 0) (void)xb_add(&bar[XB_XCNT(b.x)], 1u);
    return b;
}
__device__ __forceinline__ void xcd_barrier_complete(unsigned* bar, unsigned x, unsigned& nloc, unsigned& nx) {
    const unsigned G = gridDim.x * gridDim.y * gridDim.z;
    unsigned sum, cnt, mine, sp = 0u;
    for (;;) {
        sum = 0u; cnt = 0u; mine = 0u;
#pragma unroll
        for (unsigned j = 0; j < 16; ++j) { const unsigned c = xb_ld(&bar[XB_XCNT(j)]); sum += c; cnt += (c > 0u) ? 1u : 0u; mine = (j == x) ? c : mine; }
        if (sum == G) break;
        __builtin_amdgcn_s_sleep(1);
        if ((++sp & 255u) == 0u) { if (xb_ld(&bar[XB_TMO])) break; if (sp > XB_SPIN_CAP) { atomicAdd(&bar[XB_TMO], 1u); break; } }
    }
    nloc = mine > 0u ? mine : 1u; nx = cnt > 0u ? cnt : 1u;
}

__device__ __forceinline__ void xcd_barrier(const XcdBarrier& b) {
    asm volatile("s_waitcnt vmcnt(0)" ::: "memory");
    __syncthreads();
    if (threadIdx.x == 0) {
        unsigned* bar = b.bar;
        __builtin_amdgcn_s_waitcnt(0);
        unsigned nloc = b.st[0], nx = b.st[1];
        if (nloc == 0u) { xcd_barrier_complete(bar, b.x, nloc, nx); b.st[0] = nloc; b.st[1] = nx; }
        const unsigned old = xb_add(&bar[XB_XSUB(b.x)], 1u);
        const unsigned gen = old / nloc;
        if (old + 1u == (gen + 1u) * nloc) {
            __builtin_amdgcn_fence(__ATOMIC_RELEASE, "agent");
            asm volatile("s_waitcnt vmcnt(0)" ::: "memory");
            const unsigned og = xb_add(&bar[XB_TOP], 1u);
            const unsigned tg = og / nx;
            if (og + 1u == (tg + 1u) * nx) xb_add(&bar[XB_TOPGEN], 1u);
            else XB_SPIN(xb_ld(&bar[XB_TOPGEN]) == tg, bar);
            __builtin_amdgcn_fence(__ATOMIC_ACQUIRE, "agent");
            xb_add(&bar[XB_XGEN(b.x)], 1u);
            asm volatile("s_waitcnt vmcnt(0)" ::: "memory");
        } else {
            XB_SPIN(xb_ld(&bar[XB_XGEN(b.x)]) == gen, bar);
            __builtin_amdgcn_fence(__ATOMIC_ACQUIRE, "agent");
            asm volatile("s_waitcnt vmcnt(0)" ::: "memory");
        }
    }
    __syncthreads();
}

#ifndef USE_MFMA_MLSTM
#define USE_MFMA_MLSTM 1
#endif

#ifndef USE_MFMA_SB
#define USE_MFMA_SB 1
#endif
#ifndef USE_MFMA_MEM
#define USE_MFMA_MEM 1
#endif

constexpr int LDS_BYTES = 147456;
constexpr int LDS_TAIL = LDS_BYTES - 64;
constexpr int CW_QHEAD = 64, CW_BAR = 4096;
constexpr int N_ML = 128, N_SB = 1024, N_MEM = 1024, N_ITEMS = N_ML + N_SB + N_MEM;
struct Args {
    const float *x, *mem, *g_pre, *w_in, *conv_w, *conv_b, *i_bias, *f_bias, *g_mh, *g_sh, *g_ch, *g_mem, *w_kv, *w_out, *g_post;
    float* out; unsigned char* ws;
};

__global__ void __launch_bounds__(512, 2) hybrid_fwd(Args a) {
    extern __shared__ __attribute__((aligned(16))) unsigned char lds[];
    cg::grid_group grid = cg::this_grid();
    const int tid = threadIdx.x, lane = tid & 63, wave = __builtin_amdgcn_readfirstlane(tid >> 6);
    const int nb = (int)gridDim.x, bx = (int)blockIdx.x;
    unsigned char* ws = a.ws;
    unsigned* ctl = (unsigned*)(ws + WS_CTL);
    volatile LAS unsigned* tail = (volatile LAS unsigned*)((LAS unsigned char*)lds + LDS_TAIL);
    if (tid < 16) tail[tid] = 0u;
    __syncthreads();
    const XcdBarrier xbar = xcd_barrier_post(ctl + CW_BAR, tail);
    bf16* WIN = (bf16*)(ws + WS_WIN); bf16* WO = (bf16*)(ws + WS_WO); bf16* WKV = (bf16*)(ws + WS_WKV); float* G = (float*)(ws + WS_G);
    bf16* MEMN = (bf16*)(ws + WS_MEMN); bf16* KVM = (bf16*)(ws + WS_KVM); bf16* XN = (bf16*)(ws + WS_XN); bf16* Y = (bf16*)(ws + WS_Y); bf16* U = (bf16*)(ws + WS_U);

    { ProArgs pa{a.x, a.mem, a.g_pre, a.w_in, a.i_bias, a.f_bias, a.g_mem, a.w_kv, a.w_out, WIN, WO, WKV, XN, MEMN, G};
      phase_prologue(pa, (float*)lds, nb, bx); }
    grid.sync();

    { pg8::Gemm g{XN, WIN, M, NU, DM}; pg8::StaticOrder S; S.init(M, NU, nb, bx);
      pg8::EpiBf16<0> E{U, NU, nullptr, 0, 0, 1.f};
      pg8::gemm_phase<pg8::EpiBf16<0>, pg8::StaticOrder, true, true>((PG8_LAS unsigned char*)lds, g, S, E); }
    { pg8::Gemm g{MEMN, WKV, MMEM, 512, DM}; pg8::StaticOrder S; S.init(MMEM, 512, nb, bx);
      pg8::EpiBf16<0> E{KVM, 512, nullptr, 0, 0, 1.f};
      pg8::gemm_phase<pg8::EpiBf16<0>, pg8::StaticOrder, true, true>((PG8_LAS unsigned char*)lds, g, S, E); }
    xcd_barrier(xbar);

    for (;;) {
        if (tid == 0) tail[8] = __hip_atomic_fetch_add(ctl + CW_QHEAD, 1u, __ATOMIC_RELAXED, __HIP_MEMORY_SCOPE_AGENT);
        __syncthreads();
        const int item = (int)tail[8];
        if (item >= N_ITEMS) break;
        if (item < N_ML) ml::mlstm_unit(item >> 2, item & 3, U, G, a.conv_w, a.conv_b, a.g_mh, Y, (mx::ldsp)lds);
        else if (item < N_ML + N_SB) { const int i = item - N_ML; mx::sb_unit((i & 127) >> 2, i & 3, 7 - (i >> 7), U, a.g_sh, Y, (mx::ldsp)lds); }
        else { const int i = item - N_ML - N_SB; mx::mem_unit((i & 127) >> 2, i & 3, i >> 7, U, KVM, a.g_ch, Y, (mx::ldsp)lds); }
    }
    xcd_barrier(xbar);

    { pg8::Gemm g{Y, WO, M, DM, DM}; pg8::StaticOrder S; S.init(M, DM, nb, bx);
      pg8::EpiF32 E{a.out, DM};
      pg8::gemm_phase<pg8::EpiF32, pg8::StaticOrder, true, true>((PG8_LAS unsigned char*)lds, g, S, E); }
    xcd_barrier(xbar);

    final_rows(a.x, a.g_post, a.out, bx * 8 + wave, nb * 8, lane);
}

extern "C" void kernel_launch(void* const* d_in, const int* in_sizes, int n_in, void* d_out, int out_size, void* d_ws, size_t ws_size, hipStream_t stream) {
    static int grid_blocks = 0;
    if (grid_blocks == 0) {
        if (n_in != 15 || out_size != M * DM || ws_size < WS_END) { fprintf(stderr, "kernel_launch: unexpected shapes (n_in %d out %d ws %zu)\n", n_in, out_size, ws_size); grid_blocks = -1; return; }
        int dev = 0, cus = 0, per_cu = 0;
        (void)hipGetDevice(&dev); (void)hipDeviceGetAttribute(&cus, hipDeviceAttributeMultiprocessorCount, dev);
        if (hipFuncSetAttribute((const void*)hybrid_fwd, hipFuncAttributeMaxDynamicSharedMemorySize, LDS_BYTES) != hipSuccess) { fprintf(stderr, "kernel_launch: hipFuncSetAttribute failed\n"); grid_blocks = -1; return; }
        if (hipOccupancyMaxActiveBlocksPerMultiprocessor(&per_cu, (const void*)hybrid_fwd, 512, LDS_BYTES) != hipSuccess || per_cu < 1) { fprintf(stderr, "kernel_launch: occupancy query says %d blocks per CU\n", per_cu); per_cu = 1; }
        (void)hipGetLastError();
        if (per_cu > 1) per_cu = 1;
        grid_blocks = cus * per_cu;
    }
    if (grid_blocks < 0) return;
    Args a{};
    a.x = (const float*)d_in[0]; a.mem = (const float*)d_in[1]; a.g_pre = (const float*)d_in[2]; a.w_in = (const float*)d_in[3];
    a.conv_w = (const float*)d_in[4]; a.conv_b = (const float*)d_in[5]; a.i_bias = (const float*)d_in[6]; a.f_bias = (const float*)d_in[7];
    a.g_mh = (const float*)d_in[8]; a.g_sh = (const float*)d_in[9]; a.g_ch = (const float*)d_in[10]; a.g_mem = (const float*)d_in[11];
    a.w_kv = (const float*)d_in[12]; a.w_out = (const float*)d_in[13]; a.g_post = (const float*)d_in[14];
    a.out = (float*)d_out; a.ws = (unsigned char*)d_ws;
    (void)hipMemsetAsync((char*)d_ws + WS_CTL, 0, 65536, stream);
    void* args[] = {&a};
    hipError_t e = hipLaunchCooperativeKernel((const void*)hybrid_fwd, dim3(grid_blocks), dim3(512), args, LDS_BYTES, stream);
    if (e != hipSuccess) fprintf(stderr, "kernel_launch: cooperative launch failed: %s (grid %d)\n", hipGetErrorString(e), grid_blocks);
}
```
